# Optimizing an MI355X kernel written in HIP

```python
import math
import jax, jax.numpy as jnp
from jax import lax
import numpy as np

D_MODEL = 1024
BATCH = 32
SEQ = 2048
DEPTH = 4
DEC_BATCH = 2
DEC_SEQ = 8192
PAST_LEN = 128

N_MEM = 256
BRANCH_W = 512
N_BRANCH = 3
EPS = 1e-6
GLA_HEADS = 4
GLA_DK = 64
GLA_DV = 128
GLA_RANK = 16
GLA_TAU = 16.0
GLA_CHUNK = 64
GLA_Q = GLA_HEADS * GLA_DK
GLA_V = GLA_HEADS * GLA_DV
DIFF_HEADS = 4
DIFF_HD = 64
DIFF_DV = 2 * DIFF_HD
DIFF_QK = DIFF_HEADS * 2 * DIFF_HD
DIFF_V = DIFF_HEADS * DIFF_DV
Q_BLOCK = 128
CROSS_HEADS = 4
CROSS_HD = 128
CROSS_Q = CROSS_HEADS * CROSS_HD
SPLITS = (GLA_Q, GLA_Q, GLA_V, 2 * GLA_RANK, BRANCH_W,
          DIFF_QK, DIFF_QK, DIFF_V, BRANCH_W,
          CROSS_Q, BRANCH_W, N_BRANCH * D_MODEL)
IN_COLS = GLA_Q * 2 + GLA_V + 2 * GLA_RANK + BRANCH_W + DIFF_QK * 2 + DIFF_V + BRANCH_W + CROSS_Q + BRANCH_W + N_BRANCH * D_MODEL

kernel_name = "hybrid_gla_diffattn_memxattn_encoder"


def rmsnorm(x, g):
    xf = x.astype(jnp.float32)
    y = xf * lax.rsqrt(jnp.mean(xf * xf, axis=-1, keepdims=True) + EPS)
    return (y * g.astype(jnp.float32)).astype(x.dtype)


def gla_scan(q, k, v, log_a):
    B, H, T, DK = q.shape
    DV = v.shape[-1]
    n = T // GLA_CHUNK

    def to_chunks(a):
        return jnp.moveaxis(a.reshape(B, H, n, GLA_CHUNK, a.shape[-1]), 2, 0)

    mask = jnp.tril(jnp.ones((GLA_CHUNK, GLA_CHUNK), dtype=bool))[:, :, None]

    def step(S, inp):
        qc, kc, vc, ac = inp
        b = jnp.cumsum(ac, axis=2)
        o_inter = jnp.einsum('bhtd,bhdv->bhtv', qc * jnp.exp(b), S)
        diff = b[:, :, :, None, :] - b[:, :, None, :, :]
        decay = jnp.exp(jnp.where(mask, diff, -jnp.inf))
        att = jnp.einsum('bhtd,bhsd,bhtsd->bhts', qc, kc, decay)
        o = o_inter + jnp.einsum('bhts,bhsv->bhtv', att, vc)
        b_last = b[:, :, -1:, :]
        S = jnp.exp(b_last[:, :, 0, :])[..., None] * S + jnp.einsum(
            'bhsd,bhsv->bhdv', kc * jnp.exp(b_last - b), vc)
        return S, o

    S0 = jnp.zeros((B, H, DK, DV), jnp.float32)
    _, o = lax.scan(step, S0, (to_chunks(q), to_chunks(k), to_chunks(v), to_chunks(log_a)))
    return jnp.moveaxis(o, 0, 2).reshape(B, H, T, DV)


def gla_branch(q, k, v, glr, w2, b2, g_norm):
    B, T, _ = q.shape

    def heads(a, d):
        return a.reshape(B, T, GLA_HEADS, d).transpose(0, 2, 1, 3).astype(jnp.float32)

    qh = heads(q, GLA_DK) * (GLA_DK ** -0.5)
    kh = heads(k, GLA_DK)
    vh = heads(v, GLA_DV)
    glr = glr.astype(jnp.float32).reshape(B, T, 2, GLA_RANK)
    gate_logits = jnp.einsum('btir,irk->btik', glr, w2.astype(jnp.float32)) + b2.astype(jnp.float32)
    log_a = jax.nn.log_sigmoid(gate_logits) / GLA_TAU
    la_f = heads(log_a[:, :, 0], GLA_DK)
    la_b = heads(log_a[:, :, 1], GLA_DK)
    flip = lambda a: jnp.flip(a, axis=2)
    o_f = gla_scan(qh, kh, vh, la_f)
    o_b = flip(gla_scan(flip(qh), flip(kh), flip(vh), flip(la_b)))
    o = rmsnorm(o_f + o_b, g_norm)
    return o.transpose(0, 2, 1, 3).reshape(B, T, GLA_V)


def diff_attention(q, k, v, lam_params, g_norm, lambda_init):
    B, T, _ = q.shape
    H, HD = DIFF_HEADS, DIFF_HD
    qh = q.reshape(B, T, H, 2, HD).transpose(3, 0, 2, 1, 4).astype(jnp.float32) * (HD ** -0.5)
    kh = k.reshape(B, T, H, 2, HD).transpose(3, 0, 2, 1, 4).astype(jnp.float32)
    vh = v.reshape(B, T, H, DIFF_DV).transpose(0, 2, 1, 3).astype(jnp.float32)
    lp = lam_params.astype(jnp.float32)
    lam = jnp.exp(jnp.sum(lp[0] * lp[1])) - jnp.exp(jnp.sum(lp[2] * lp[3])) + lambda_init
    slopes = 2.0 ** (-8.0 * (jnp.arange(H, dtype=jnp.float32) + 1.0) / H)
    pos = jnp.arange(T, dtype=jnp.float32)
    nb = T // Q_BLOCK
    qb = qh.reshape(2, B, H, nb, Q_BLOCK, HD).transpose(3, 0, 1, 2, 4, 5)
    starts = jnp.arange(nb, dtype=jnp.int32) * Q_BLOCK

    def block(inp):
        qblk, t0 = inp
        tq = t0.astype(jnp.float32) + jnp.arange(Q_BLOCK, dtype=jnp.float32)
        bias = -slopes[:, None, None] * jnp.abs(tq[:, None] - pos[None, :])
        s = jnp.einsum('ibhqd,ibhkd->ibhqk', qblk, kh) + bias
        p = jax.nn.softmax(s, axis=-1)
        a = p[0] - lam * p[1]
        return jnp.einsum('bhqk,bhkv->bhqv', a, vh)

    o = lax.map(block, (qb, starts))
    o = o.transpose(1, 2, 0, 3, 4).reshape(B, H, T, DIFF_DV)
    o = rmsnorm(o, g_norm) * (1.0 - lambda_init)
    return o.transpose(0, 2, 1, 3).reshape(B, T, DIFF_V)


def memory_cross_attention(q, mem, mem_norm_g, w_kv):
    B, T, _ = q.shape
    M = mem.shape[1]
    m = rmsnorm(mem, mem_norm_g)
    kv = jnp.einsum('bmd,de->bme', m, w_kv)
    kh = kv[..., :CROSS_Q].reshape(B, M, CROSS_HEADS, CROSS_HD).astype(jnp.float32)
    vh = kv[..., CROSS_Q:].reshape(B, M, CROSS_HEADS, CROSS_HD).astype(jnp.float32)
    qh = q.reshape(B, T, CROSS_HEADS, CROSS_HD).astype(jnp.float32) * (CROSS_HD ** -0.5)
    p = jax.nn.softmax(jnp.einsum('bthd,bmhd->bhtm', qh, kh), axis=-1)
    o = jnp.einsum('bhtm,bmhd->bthd', p, vh)
    return o.reshape(B, T, CROSS_Q)


def trunk(x, mem, norm_g, w_in, gla_gate_w2, gla_gate_b, gla_norm_g, diff_lambda,
          diff_norm_g, mem_norm_g, w_mem_kv, w_branch, w_out, final_norm_g):
    B, T, D = x.shape
    offsets = [int(o) for o in np.cumsum(np.array(SPLITS))[:-1]]
    for l in range(DEPTH):
        lambda_init = 0.8 - 0.6 * math.exp(-0.3 * l)
        h = rmsnorm(x, norm_g[l])
        proj = jnp.einsum('btd,de->bte', h, w_in[l])
        (g_q, g_k, g_v, g_lr, z_a, d_q, d_k, d_v, z_b, c_q, z_c, gate_in) = jnp.split(proj, offsets, axis=-1)
        o_a = gla_branch(g_q, g_k, g_v, g_lr, gla_gate_w2[l], gla_gate_b[l], gla_norm_g[l]).astype(x.dtype) * jax.nn.silu(z_a)
        o_b = diff_attention(d_q, d_k, d_v, diff_lambda[l], diff_norm_g[l], lambda_init).astype(x.dtype) * jax.nn.silu(z_b)
        o_c = memory_cross_attention(c_q, mem, mem_norm_g[l], w_mem_kv[l]).astype(x.dtype) * jax.nn.silu(z_c)
        branches = jnp.stack([o_a, o_b, o_c], axis=2)
        gates = jax.nn.sigmoid(gate_in.reshape(B, T, N_BRANCH, D))
        merged = jnp.sum(gates * jnp.einsum('btiw,iwd->btid', branches, w_branch[l]), axis=2)
        x = x + jnp.einsum('btd,de->bte', merged, w_out[l])
    return rmsnorm(x, final_norm_g)


def setup_inputs(seed: int = 0) -> dict:
    key = jax.random.key(seed)
    ks = jax.random.split(key, 17)
    f32 = jnp.float32
    nrm = lambda k, s: jax.random.normal(k, s, f32)
    return {
        "x_prompt": nrm(ks[0], (BATCH, SEQ, D_MODEL)),
        "x_sample": nrm(ks[1], (DEC_BATCH, DEC_SEQ, D_MODEL)),
        "mem_prompt": nrm(ks[2], (BATCH, N_MEM, D_MODEL)),
        "mem_sample": nrm(ks[3], (DEC_BATCH, N_MEM, D_MODEL)),
        "norm_g": 1.0 + 0.02 * nrm(ks[4], (DEPTH, D_MODEL)),
        "w_in": nrm(ks[5], (DEPTH, D_MODEL, IN_COLS)) * D_MODEL ** -0.5,
        "gla_gate_w2": nrm(ks[6], (DEPTH, 2, GLA_RANK, GLA_Q)) * GLA_RANK ** -0.5,
        "gla_gate_b": 0.1 * nrm(ks[7], (DEPTH, 2, GLA_Q)),
        "gla_norm_g": 1.0 + 0.02 * nrm(ks[8], (DEPTH, GLA_DV)),
        "diff_lambda": 0.1 * nrm(ks[9], (DEPTH, 4, DIFF_HD)),
        "diff_norm_g": 1.0 + 0.02 * nrm(ks[10], (DEPTH, DIFF_DV)),
        "mem_norm_g": 1.0 + 0.02 * nrm(ks[11], (DEPTH, D_MODEL)),
        "w_mem_kv": nrm(ks[12], (DEPTH, D_MODEL, 2 * CROSS_Q)) * D_MODEL ** -0.5,
        "w_branch": nrm(ks[13], (DEPTH, N_BRANCH, BRANCH_W, D_MODEL)) * BRANCH_W ** -0.5,
        "w_out": nrm(ks[14], (DEPTH, D_MODEL, D_MODEL)) * D_MODEL ** -0.5,
        "final_norm_g": 1.0 + 0.02 * nrm(ks[15], (D_MODEL,)),
    }


def reference(x_prompt, x_sample, mem_prompt, mem_sample, norm_g, w_in, gla_gate_w2, gla_gate_b,
              gla_norm_g, diff_lambda, diff_norm_g, mem_norm_g, w_mem_kv, w_branch, w_out, final_norm_g):
    y_prompt = trunk(x_prompt, mem_prompt, norm_g, w_in, gla_gate_w2, gla_gate_b, gla_norm_g, diff_lambda,
                     diff_norm_g, mem_norm_g, w_mem_kv, w_branch, w_out, final_norm_g)
    y_sample = trunk(x_sample, mem_sample, norm_g, w_in, gla_gate_w2, gla_gate_b, gla_norm_g, diff_lambda,
                     diff_norm_g, mem_norm_g, w_mem_kv, w_branch, w_out, final_norm_g)
    return (y_prompt, y_sample)
```

```cpp
#include <hip/hip_runtime.h>
#include <hip/hip_cooperative_groups.h>
#include <cstdio>
#include <cmath>
namespace cg = cooperative_groups;

typedef unsigned short bf16;
using bf16x8 = __attribute__((ext_vector_type(8))) short;
using s16x4  = __attribute__((ext_vector_type(4))) short;
using f32x16 = __attribute__((ext_vector_type(16))) float;
typedef __bf16 v2bf __attribute__((ext_vector_type(2)));
#define DI __device__ __forceinline__
#define MFMA(a, b, c) __builtin_amdgcn_mfma_f32_32x32x16_bf16((a), (b), (c), 0, 0, 0)

constexpr int DM = 1024;
constexpr int NIN = 8192;
constexpr int MG = 16384;
constexpr int NGROUP = 5;
constexpr int NLAYER = 4;
constexpr int WIN_COLS = 7712;
constexpr int MEMROWS = 34 * 256;
constexpr int C_GQ = 0, C_GK = 256, C_GV = 512, C_LA = 1024, C_ZA = 1536, C_DQ = 2048, C_DK = 2560,
              C_DV = 3072, C_ZB = 3584, C_CQ = 4096, C_ZC = 4608, C_GATE = 5120;
constexpr float LOG2E = 1.4426950408889634f;
constexpr float EPSN = 1e-6f;
constexpr int SMEM_BYTES = 73728;

struct Params {
  const float *x_prompt, *x_sample, *mem_prompt, *mem_sample, *norm_g, *w_in, *w2, *b2, *gla_norm_g,
      *diff_lambda, *diff_norm_g, *mem_norm_g, *w_mem_kv, *w_branch, *w_out, *final_g;
  float* out;
  bf16 *Win, *Wkv, *Wb, *Wout, *memn, *kmem, *vmemT, *xn, *proj, *dvT, *gvT, *br, *merged;
  float *la, *glao, *park;
  int* counters;
  unsigned* bar;
  int* knmax;
  int* pad_ptr;
  float lam_init[4];
};

struct Grp { int nseq, T, tok0, mem0; };
DI Grp get_grp(int g) {
  Grp G;
  if (g < 4) { G.nseq = 8; G.T = 2048; G.tok0 = g * MG; G.mem0 = g * 8; }
  else { G.nseq = 2; G.T = 8192; G.tok0 = 65536; G.mem0 = 32; }
  return G;
}

DI int otid() { int t = threadIdx.x; asm volatile("" : "+v"(t)); return t; }
DI float bf2f(bf16 b) { return __uint_as_float(((unsigned)b) << 16); }
DI unsigned pack2(float a, float b) { v2bf v = {(__bf16)a, (__bf16)b}; return __builtin_bit_cast(unsigned, v); }
DI bf16 f2bf(float a) { return (bf16)(pack2(a, 0.f) & 0xffffu); }
DI int crow(int r, int hh) { return (r & 3) + 8 * (r >> 2) + 4 * hh; }
DI float fexp2(float x) { return __builtin_amdgcn_exp2f(x); }
DI float sigmf(float x) { return __builtin_amdgcn_rcpf(1.f + __builtin_amdgcn_exp2f(-LOG2E * x)); }
DI float siluf(float x) { return x * sigmf(x); }
DI float logsigf(float x) { return fminf(x, 0.f) - 0.6931471805599453f * __builtin_amdgcn_logf(1.f + __builtin_amdgcn_exp2f(-LOG2E * fabsf(x))); }

template <int S>
DI bf16x8 pack8(const f32x16& x) {
  unsigned p0 = pack2(x[8 * S + 0], x[8 * S + 1]);
  unsigned p1 = pack2(x[8 * S + 2], x[8 * S + 3]);
  unsigned p2 = pack2(x[8 * S + 4], x[8 * S + 5]);
  unsigned p3 = pack2(x[8 * S + 6], x[8 * S + 7]);
  uint4 u = make_uint4(p0, p1, p2, p3);
  return __builtin_bit_cast(bf16x8, u);
}
DI bf16x8 ld_perm(const bf16* p) {
  s16x4 lo = *reinterpret_cast<const s16x4*>(p);
  s16x4 hi = *reinterpret_cast<const s16x4*>(p + 8);
  return __builtin_shufflevector(lo, hi, 0, 1, 2, 3, 4, 5, 6, 7);
}

DI float win_src(const float* __restrict__ w, const float* __restrict__ w2, int k, int n) {
  if (n >= C_LA && n < C_ZA) {
    int dir = (n - C_LA) >> 8, j = (n - C_LA) & 255;
    float s = 0.f;
#pragma unroll
    for (int r = 0; r < 16; ++r) s += w[(long)k * WIN_COLS + 1024 + dir * 16 + r] * w2[(dir * 16 + r) * 256 + j];
    return s;
  }
  int src; float sc = 1.f;
  if (n < 1024) { src = n; if (n < 256) sc = 0.125f; }
  else if (n < C_DQ) src = 1056 + n - C_ZA;
  else if (n < C_DK) { src = 1568 + n - C_DQ; sc = 0.125f * LOG2E; }
  else if (n < C_DV) src = 2080 + n - C_DK;
  else if (n < C_ZB) src = 2592 + n - C_DV;
  else if (n < C_CQ) src = 3104 + n - C_ZB;
  else if (n < C_ZC) { src = 3616 + n - C_CQ; sc = 0.08838834764831845f * LOG2E; }
  else if (n < C_GATE) src = 4128 + n - C_ZC;
  else src = 4640 + n - C_GATE;
  return w[(long)k * WIN_COLS + src] * sc;
}

constexpr int PREP_TILES = 8192 + 1024 + 1536 + 1024;
constexpr int PREP_L0 = 2048 + 256 + 384 + 256;
constexpr int PREP_DEF = PREP_TILES - PREP_L0;
DI int prep_l0_tile(int d) {
  if (d < 2048) return d;
  if (d < 2304) return 8192 + (d - 2048);
  if (d < 2688) return 9216 + (d - 2304);
  return 10752 + (d - 2688);
}
DI int prep_def_tile(int d) {
  if (d < 6144) return 2048 + d;
  if (d < 6912) return 8192 + 256 + (d - 6144);
  if (d < 8064) return 9216 + 384 + (d - 6912);
  return 10752 + 256 + (d - 8064);
}
DI void prep_tile(const Params& p, int tile, char* smem) {
  float* ts = reinterpret_cast<float*>(smem);
  const int tid = otid();
  int kind, l, bi = 0, kt, nt, Kdim;
  if (tile < 8192) { kind = 0; l = tile / 2048; int r = tile % 2048; kt = r / 128; nt = r % 128; Kdim = 1024; }
  else if (tile < 9216) { kind = 1; int t = tile - 8192; l = t / 256; int r = t % 256; kt = r / 16; nt = r % 16; Kdim = 1024; }
  else if (tile < 10752) { kind = 2; int t = tile - 9216; l = t / 384; int r = t % 384; bi = r / 128; int r2 = r % 128; kt = r2 / 16; nt = r2 % 16; Kdim = 512; }
  else { kind = 3; int t = tile - 10752; l = t / 256; int r = t % 256; kt = r / 16; nt = r % 16; Kdim = 1024; }
  const int k0 = kt * 64, n0 = nt * 64;
  const int nn = tid & 63, kq = tid >> 6;
#pragma unroll 4
  for (int i = 0; i < 16; ++i) {
    int kk = kq + 4 * i, k = k0 + kk, n = n0 + nn;
    float v;
    if (kind == 0) v = win_src(p.w_in + (long)l * 1024 * WIN_COLS, p.w2 + l * 2 * 16 * 256, k, n) * p.norm_g[l * 1024 + k];
    else if (kind == 1) v = p.w_mem_kv[((long)l * 1024 + k) * 1024 + n] * p.mem_norm_g[l * 1024 + k];
    else if (kind == 2) v = p.w_branch[((long)(l * 3 + bi) * 512 + k) * 1024 + n];
    else v = p.w_out[((long)l * 1024 + k) * 1024 + n];
    ts[kk * 65 + nn] = v;
  }
  __syncthreads();
  bf16* dst;
  if (kind == 0) dst = p.Win + (long)l * NIN * 1024;
  else if (kind == 1) dst = p.Wkv + (long)l * 1024 * 1024;
  else if (kind == 2) dst = p.Wb + (long)l * 1024 * 1536 + bi * 512;
  else dst = p.Wout + (long)l * 1024 * 1024;
#pragma unroll 4
  for (int i = 0; i < 16; ++i) {
    int nn2 = kq + 4 * i;
    dst[(long)(n0 + nn2) * (kind == 2 ? 1536 : Kdim) + k0 + nn] = f2bf(ts[nn * 65 + nn2]);
  }
  __syncthreads();
}

DI float wave_sum(float v) {
#pragma unroll
  for (int o = 32; o >= 1; o >>= 1) v += __shfl_xor(v, o);
  return v;
}
DI void rownorm_bf16_row(const float* __restrict__ src, bf16* __restrict__ dst, int lane) {
  float4 v[4]; float ss = 0.f;
#pragma unroll
  for (int i = 0; i < 4; ++i) { v[i] = reinterpret_cast<const float4*>(src)[lane + 64 * i]; ss += v[i].x * v[i].x + v[i].y * v[i].y + v[i].z * v[i].z + v[i].w * v[i].w; }
  ss = wave_sum(ss);
  float rs = rsqrtf(ss * (1.f / 1024.f) + EPSN);
#pragma unroll
  for (int i = 0; i < 4; ++i) {
    uint2 o = make_uint2(pack2(v[i].x * rs, v[i].y * rs), pack2(v[i].z * rs, v[i].w * rs));
    reinterpret_cast<uint2*>(dst)[lane + 64 * i] = o;
  }
}
DI void rownorm_final_row(float* __restrict__ row, const float* __restrict__ g, int lane) {
  float4 v[4]; float ss = 0.f;
#pragma unroll
  for (int i = 0; i < 4; ++i) { v[i] = reinterpret_cast<const float4*>(row)[lane + 64 * i]; ss += v[i].x * v[i].x + v[i].y * v[i].y + v[i].z * v[i].z + v[i].w * v[i].w; }
  ss = wave_sum(ss);
  float rs = rsqrtf(ss * (1.f / 1024.f) + EPSN);
#pragma unroll
  for (int i = 0; i < 4; ++i) {
    float4 gg = reinterpret_cast<const float4*>(g)[lane + 64 * i];
    float4 o = make_float4(v[i].x * rs * gg.x, v[i].y * rs * gg.y, v[i].z * rs * gg.z, v[i].w * rs * gg.w);
    reinterpret_cast<float4*>(row)[lane + 64 * i] = o;
  }
}

DI void rownorm_bf16_rows4(const float* __restrict__ src, bf16* __restrict__ dst, long r0, long rstride, int lane) {
  float4 v[4][4]; float ss[4];
#pragma unroll
  for (int k = 0; k < 4; ++k) {
    const float4* s4 = reinterpret_cast<const float4*>(src + (r0 + k * rstride) * 1024);
#pragma unroll
    for (int i = 0; i < 4; ++i) v[k][i] = s4[lane + 64 * i];
  }
#pragma unroll
  for (int k = 0; k < 4; ++k) {
    float a = 0.f;
#pragma unroll
    for (int i = 0; i < 4; ++i) a += v[k][i].x * v[k][i].x + v[k][i].y * v[k][i].y + v[k][i].z * v[k][i].z + v[k][i].w * v[k][i].w;
    ss[k] = a;
  }
#pragma unroll
  for (int o = 32; o >= 1; o >>= 1) {
#pragma unroll
    for (int k = 0; k < 4; ++k) ss[k] += __shfl_xor(ss[k], o);
  }
#pragma unroll
  for (int k = 0; k < 4; ++k) {
    const float rs = rsqrtf(ss[k] * (1.f / 1024.f) + EPSN);
    uint2* d2 = reinterpret_cast<uint2*>(dst + (r0 + k * rstride) * 1024);
#pragma unroll
    for (int i = 0; i < 4; ++i)
      d2[lane + 64 * i] = make_uint2(pack2(v[k][i].x * rs, v[k][i].y * rs), pack2(v[k][i].z * rs, v[k][i].w * rs));
  }
}

constexpr int GSTR = 72;
constexpr int GBUF = 2 * 128 * GSTR;
#define GEMM_LDG(R, kk)                                                     \
  R##a0 = *reinterpret_cast<const uint4*>(Ap + (kk));                      \
  R##a1 = *reinterpret_cast<const uint4*>(Ap + (long)32 * lda + (kk));     \
  R##a2 = *reinterpret_cast<const uint4*>(Ap + (long)64 * lda + (kk));     \
  R##a3 = *reinterpret_cast<const uint4*>(Ap + (long)96 * lda + (kk));     \
  R##b0 = *reinterpret_cast<const uint4*>(Bp + (kk));                      \
  R##b1 = *reinterpret_cast<const uint4*>(Bp + (long)32 * ldb + (kk));     \
  R##b2 = *reinterpret_cast<const uint4*>(Bp + (long)64 * ldb + (kk));     \
  R##b3 = *reinterpret_cast<const uint4*>(Bp + (long)96 * ldb + (kk));
#define GEMM_STS(R, bufo)                                                     \
  *reinterpret_cast<uint4*>(Asw + (bufo)) = R##a0;                            \
  *reinterpret_cast<uint4*>(Asw + (bufo) + 32 * GSTR) = R##a1;                \
  *reinterpret_cast<uint4*>(Asw + (bufo) + 64 * GSTR) = R##a2;                \
  *reinterpret_cast<uint4*>(Asw + (bufo) + 96 * GSTR) = R##a3;                \
  *reinterpret_cast<uint4*>(Asw + (bufo) + 128 * GSTR) = R##b0;               \
  *reinterpret_cast<uint4*>(Asw + (bufo) + 160 * GSTR) = R##b1;               \
  *reinterpret_cast<uint4*>(Asw + (bufo) + 192 * GSTR) = R##b2;               \
  *reinterpret_cast<uint4*>(Asw + (bufo) + 224 * GSTR) = R##b3;
#define GEMM_COMPUTE(bufo)                                                                                                   \
  {                                                                                                                          \
    const bf16* Asr = As + (bufo);                                                                                           \
    const bf16* Bsr = Asr + 128 * GSTR;                                                                                      \
    _Pragma("unroll") for (int ks = 0; ks < 4; ++ks) {                                                                       \
      bf16x8 a[2], b[2];                                                                                                     \
      _Pragma("unroll") for (int i = 0; i < 2; ++i)                                                                          \
          a[i] = *reinterpret_cast<const bf16x8*>(Asr + (wm * 64 + i * 32 + l31) * GSTR + ks * 16 + hh * 8);                 \
      _Pragma("unroll") for (int j = 0; j < 2; ++j)                                                                          \
          b[j] = *reinterpret_cast<const bf16x8*>(Bsr + (wn * 64 + j * 32 + l31) * GSTR + ks * 16 + hh * 8);                 \
      _Pragma("unroll") for (int i = 0; i < 2; ++i)                                                                          \
        _Pragma("unroll") for (int j = 0; j < 2; ++j) acc[i][j] = MFMA(a[i], b[j], acc[i][j]);                               \
    }                                                                                                                        \
  }
DI void gemm_mainloop(const bf16* __restrict__ A, int lda, const bf16* __restrict__ B, int ldb, int K,
                      f32x16 (&acc)[2][2], char* smem) {
  bf16* As = reinterpret_cast<bf16*>(smem);
  const int tid = otid(), lane = tid & 63, wave = tid >> 6, wm = wave >> 1, wn = wave & 1, hh = lane >> 5, l31 = lane & 31;
  uint4 pa0, pa1, pa2, pa3, pb0, pb1, pb2, pb3;
  uint4 qa0, qa1, qa2, qa3, qb0, qb1, qb2, qb3;
  const int lrow = tid >> 3, lc = tid & 7;
  const bf16* Ap = A + (long)lrow * lda + lc * 8;
  const bf16* Bp = B + (long)lrow * ldb + lc * 8;
  bf16* Asw = As + lrow * GSTR + lc * 8;
  GEMM_LDG(p, 0)
  GEMM_LDG(q, 64)
  GEMM_STS(p, 0)
  if (K > 128) { GEMM_LDG(p, 128) }
  __syncthreads();
  for (int k0 = 0; k0 < K; k0 += 128) {
    GEMM_STS(q, GBUF)
    if (k0 + 192 < K) { GEMM_LDG(q, k0 + 192) }
    GEMM_COMPUTE(0)
    __syncthreads();
    if (k0 + 128 < K) { GEMM_STS(p, 0) }
    if (k0 + 256 < K) { GEMM_LDG(p, k0 + 256) }
    GEMM_COMPUTE(GBUF)
    __syncthreads();
  }
}

DI void gemm_mainloop1(const bf16* __restrict__ A, int lda, const bf16* __restrict__ B, int ldb, int K,
                       f32x16 (&acc)[2][2], char* smem) {
  bf16* As = reinterpret_cast<bf16*>(smem);
  const int tid = otid(), lane = tid & 63, wave = tid >> 6, wm = wave >> 1, wn = wave & 1, hh = lane >> 5, l31 = lane & 31;
  uint4 pa0, pa1, pa2, pa3, pb0, pb1, pb2, pb3;
  const int lrow = tid >> 3, lc = tid & 7;
  const bf16* Ap = A + (long)lrow * lda + lc * 8;
  const bf16* Bp = B + (long)lrow * ldb + lc * 8;
  bf16* Asw = As + lrow * GSTR + lc * 8;
  GEMM_LDG(p, 0)
  GEMM_STS(p, 0)
  GEMM_LDG(p, 64)
  __syncthreads();
  for (int k0 = 0; k0 < K; k0 += 128) {
    GEMM_STS(p, GBUF)
    if (k0 + 128 < K) { GEMM_LDG(p, k0 + 128) }
    GEMM_COMPUTE(0)
    __syncthreads();
    if (k0 + 128 < K) { GEMM_STS(p, 0) }
    if (k0 + 192 < K) { GEMM_LDG(p, k0 + 192) }
    GEMM_COMPUTE(GBUF)
    __syncthreads();
  }
}

DI void zero_acc(f32x16 (&acc)[2][2]) {
#pragma unroll
  for (int i = 0; i < 2; ++i)
#pragma unroll
    for (int j = 0; j < 2; ++j)
#pragma unroll
      for (int r = 0; r < 16; ++r) acc[i][j][r] = 0.f;
}

constexpr int CSTR = 132;
template <int MODE>
DI void epi_pack_store(const f32x16 (&acc)[2][2], bf16* __restrict__ dst, long ld, char* smem) {
  bf16* Cs = reinterpret_cast<bf16*>(smem);
  const int tid = otid(), lane = tid & 63, wave = tid >> 6, wm = wave >> 1, wn = wave & 1, hh = lane >> 5, l31 = lane & 31;
#pragma unroll
  for (int i = 0; i < 2; ++i)
#pragma unroll
    for (int j = 0; j < 2; ++j)
#pragma unroll
      for (int rq = 0; rq < 4; ++rq) {
        float v0 = acc[i][j][4 * rq], v1 = acc[i][j][4 * rq + 1], v2 = acc[i][j][4 * rq + 2], v3 = acc[i][j][4 * rq + 3];
        if (MODE == 1) { v0 = siluf(v0); v1 = siluf(v1); v2 = siluf(v2); v3 = siluf(v3); }
        else if (MODE == 2) { v0 = sigmf(v0); v1 = sigmf(v1); v2 = sigmf(v2); v3 = sigmf(v3); }
        const int s = wn * 64 + j * 32 + l31, f = wm * 64 + i * 32 + 8 * rq + 4 * hh;
        *reinterpret_cast<uint2*>(Cs + s * CSTR + f) = make_uint2(pack2(v0, v1), pack2(v2, v3));
      }
  __syncthreads();
#pragma unroll
  for (int it = 0; it < 16; ++it) {
    const int id = tid + it * 256, s = id >> 5, c = id & 31;
    const uint2 v = *reinterpret_cast<const uint2*>(Cs + s * CSTR + c * 4);
    __builtin_nontemporal_store(__builtin_bit_cast(unsigned long long, v), reinterpret_cast<unsigned long long*>(dst + (long)s * ld + c * 4));
  }
  __syncthreads();
}

DI void gin_tile(const Params& p, const Grp& G, int l, int gslot, int tile, char* smem) {
  const int mt = tile >> 6, nt = tile & 63, m0 = mt * 128, n0 = nt * 128;
  const bool is_la = (n0 >= C_LA && n0 < C_ZA);
  const bool tr_gv = (n0 >= C_GV && n0 < C_LA), tr_dv = (n0 >= C_DV && n0 < C_ZB);
  const bool swp = !(is_la || tr_gv || tr_dv);
  const bf16* Xp = p.xn + (long)m0 * 1024;
  const bf16* Wp = p.Win + ((long)l * NIN + n0) * 1024;
  f32x16 acc[2][2];
  zero_acc(acc);
  gemm_mainloop(swp ? Wp : Xp, 1024, swp ? Xp : Wp, 1024, 1024, acc, smem);
  if (is_la) {
    const int tid = otid(), lane = tid & 63, wave = tid >> 6, wm = wave >> 1, wn = wave & 1, hh = lane >> 5, l31 = lane & 31;
    const float* b2 = p.b2 + l * 512;
#pragma unroll
    for (int i = 0; i < 2; ++i)
#pragma unroll
      for (int j = 0; j < 2; ++j) {
        int cn = n0 - C_LA + wn * 64 + j * 32 + l31;
        float bb = b2[cn];
#pragma unroll
        for (int r = 0; r < 16; ++r) {
          int row = m0 + wm * 64 + i * 32 + crow(r, hh);
          p.la[(long)row * 512 + cn] = logsigf(acc[i][j][r] + bb) * 0.0625f;
        }
      }
  } else if (tr_gv || tr_dv) {
    int head = tr_gv ? (n0 - C_GV) >> 7 : (n0 - C_DV) >> 7;
    int seq = m0 / G.T, t0 = m0 % G.T;
    bf16* base = (tr_gv ? p.gvT : p.dvT) + (long)((seq * 4 + head) * 128) * G.T + t0;
    epi_pack_store<0>(acc, base, G.T, smem);
  } else {
    if (n0 >= C_DK && n0 < C_DV) {
      const int tid = otid(), lane = tid & 63, wave = tid >> 6, wm = wave >> 1;
      float v = 0.f;
#pragma unroll
      for (int j = 0; j < 2; ++j) {
        float ss = 0.f;
#pragma unroll
        for (int i = 0; i < 2; ++i)
#pragma unroll
          for (int r = 0; r < 16; ++r) ss += acc[i][j][r] * acc[i][j][r];
        ss += __shfl_xor(ss, 32);
        v = fmaxf(v, ss);
      }
#pragma unroll
      for (int o = 16; o >= 1; o >>= 1) v = fmaxf(v, __shfl_xor(v, o));
      if (lane == 0) atomicMax(p.knmax + (gslot * 8 + m0 / G.T) * 8 + ((n0 - C_DK) >> 7) * 2 + wm, __float_as_int(v));
    }
    bf16* dstp = p.proj + (long)m0 * NIN + n0;
    if ((n0 >= C_ZA && n0 < C_DQ) || (n0 >= C_ZB && n0 < C_CQ) || (n0 >= C_ZC && n0 < C_GATE)) epi_pack_store<1>(acc, dstp, NIN, smem);
    else if (n0 >= C_GATE) epi_pack_store<2>(acc, dstp, NIN, smem);
    else epi_pack_store<0>(acc, dstp, NIN, smem);
  }
}

constexpr int GKV_TILES = NLAYER * 68 * 8;
DI void gkv_tile(const Params& p, int u, char* smem) {
  const int l = u / 544, r = u % 544, mt = r >> 3, nt = r & 7;
  const bool swp = nt < 4;
  const bf16* Xp = p.memn + (long)mt * 128 * 1024;
  const bf16* Wp = p.Wkv + ((long)l * 1024 + nt * 128) * 1024;
  f32x16 acc[2][2];
  zero_acc(acc);
  gemm_mainloop(swp ? Wp : Xp, 1024, swp ? Xp : Wp, 1024, 1024, acc, smem);
  if (swp) {
    epi_pack_store<0>(acc, p.kmem + ((long)l * MEMROWS + mt * 128) * 512 + nt * 128, 512, smem);
  } else {
    int head = nt - 4, b = mt >> 1, mrow0 = (mt & 1) * 128;
    epi_pack_store<0>(acc, p.vmemT + (long)l * (34 * 4 * 128 * 256) + (long)((b * 4 + head) * 128) * 256 + mrow0, 256, smem);
  }
}

template <int HD, int NS, bool ALIBI>
DI void attn_pass(const bf16* __restrict__ Q, int ldq, const bf16* __restrict__ Kg, int ldk,
                  const bf16* __restrict__ VTg, int ldvt, int nkeys, int kstart, float slope2, float qpos, int kcol0,
                  const int* __restrict__ kn2p, f32x16 (&O)[4], float& linv, char* smem) {
  constexpr int KSTR = HD + 8, VSTR = 68, KCH = HD / 8, KPT = 64 * KCH / 256;
  bf16* Ks = reinterpret_cast<bf16*>(smem);
  bf16* VTs = Ks + 64 * KSTR;
  const int tid = otid(), lane = tid & 63, wave = tid >> 6, hh = lane >> 5, l31 = lane & 31;
  bf16x8 qf[NS];
#pragma unroll
  for (int s = 0; s < NS; ++s) qf[s] = *reinterpret_cast<const bf16x8*>(Q + (long)l31 * ldq + s * 16 + hh * 8);
  uint4 kr0, kr1, kr2, kr3, vr0, vr1, vr2, vr3;
  kr2 = make_uint4(0, 0, 0, 0); kr3 = kr2;
  const int krow_ = tid / KCH, kc_ = tid % KCH;
  constexpr int KRS = 256 / KCH;
  const int vrow_ = tid >> 3, vc_ = tid & 7;
  const bf16* Kp = Kg + (long)krow_ * ldk + kc_ * 8;
  const bf16* Vp = VTg + (long)vrow_ * ldvt + vc_ * 8;
#define ATT_LDG(kk)                                                                   \
  kr0 = *reinterpret_cast<const uint4*>(Kp + (long)(kk) * ldk);                        \
  kr1 = *reinterpret_cast<const uint4*>(Kp + (long)((kk) + KRS) * ldk);                \
  if (KPT > 2) {                                                                      \
    kr2 = *reinterpret_cast<const uint4*>(Kp + (long)((kk) + 2 * KRS) * ldk);          \
    kr3 = *reinterpret_cast<const uint4*>(Kp + (long)((kk) + 3 * KRS) * ldk);          \
  }                                                                                   \
  vr0 = *reinterpret_cast<const uint4*>(Vp + (kk));                                    \
  vr1 = *reinterpret_cast<const uint4*>(Vp + (long)32 * ldvt + (kk));                  \
  vr2 = *reinterpret_cast<const uint4*>(Vp + (long)64 * ldvt + (kk));                  \
  vr3 = *reinterpret_cast<const uint4*>(Vp + (long)96 * ldvt + (kk));
  int wlo = 0, whi = nkeys;
  if (ALIBI) {
    float ss = 0.f;
#pragma unroll
    for (int s = 0; s < NS; ++s)
#pragma unroll
      for (int e = 0; e < 8; ++e) { float qv = bf2f((bf16)qf[s][e]); ss += qv * qv; }
    ss += __shfl_xor(ss, 32);
#pragma unroll
    for (int o = 16; o >= 1; o >>= 1) ss = fmaxf(ss, __shfl_xor(ss, o));
    const float kn2 = __int_as_float(__hip_atomic_load(kn2p, __ATOMIC_RELAXED, __HIP_MEMORY_SCOPE_AGENT));
    const float Dw = (2.04f * sqrtf(ss * kn2) + 40.f) / slope2;
    float* xd = reinterpret_cast<float*>(smem + 70656);
    if (lane == 0) xd[wave] = Dw;
    __syncthreads();
    const float D = fmaxf(fmaxf(xd[0], xd[1]), fmaxf(xd[2], xd[3]));
    const float lo = (float)kstart - D, hi = (float)(kstart + 64) + D;
    if (lo > 0.f) wlo = ((int)lo) & ~63;
    if (hi < (float)nkeys) { int h = (((int)hi) + 64) & ~63; whi = h < nkeys ? h : nkeys; }
  }
  const int wspan = whi - wlo;
  const int ntile = wspan >> 6;
#define ATT_WRAP(i) ((kstart + ((i) << 6)) >= whi ? (kstart + ((i) << 6)) - wspan : (kstart + ((i) << 6)))
  { const int kw = ATT_WRAP(0); ATT_LDG(kw) }
  constexpr int ASTG = 64 * KSTR + 128 * VSTR;
  bf16* Ksw = Ks + krow_ * KSTR + kc_ * 8;
  bf16* Vsw = VTs + vrow_ * VSTR + vc_ * 8;
#define ATT_STV(bo, off, v)                                                        \
    reinterpret_cast<uint2*>(Vsw + (bo) + (off) * VSTR)[0] = make_uint2(v.x, v.y); \
    reinterpret_cast<uint2*>(Vsw + (bo) + (off) * VSTR)[1] = make_uint2(v.z, v.w);
#define ATT_STS(bo)                                                           \
    *reinterpret_cast<uint4*>(Ksw + (bo)) = kr0;                              \
    *reinterpret_cast<uint4*>(Ksw + (bo) + KRS * KSTR) = kr1;                 \
    if (KPT > 2) {                                                            \
      *reinterpret_cast<uint4*>(Ksw + (bo) + 2 * KRS * KSTR) = kr2;           \
      *reinterpret_cast<uint4*>(Ksw + (bo) + 3 * KRS * KSTR) = kr3;           \
    }                                                                         \
    ATT_STV(bo, 0, vr0) ATT_STV(bo, 32, vr1) ATT_STV(bo, 64, vr2) ATT_STV(bo, 96, vr3)
  float m_run = -1e30f, l_run = 0.f;
#pragma unroll
  for (int dt = 0; dt < 4; ++dt)
#pragma unroll
    for (int r = 0; r < 16; ++r) O[dt][r] = 0.f;
  ATT_STS(0)
  if (ntile > 1) { const int kw = ATT_WRAP(1); ATT_LDG(kw) }
  __syncthreads();
  const float qk = qpos - (float)(4 * hh);
  for (int it = 0; it < ntile; ++it) {
    const int cur = it & 1;
    if (it + 1 < ntile) { const int bo = (cur ^ 1) * ASTG; ATT_STS(bo) }
    if (it + 2 < ntile) { const int kw = ATT_WRAP(it + 2); ATT_LDG(kw) }
    const int k0 = ATT_WRAP(it);
    const float qk0 = qk - (float)k0;
    const bf16* Ksr = Ks + cur * ASTG;
    const bf16* VTr = VTs + cur * ASTG;
    f32x16 st[2];
#pragma unroll
    for (int mt = 0; mt < 2; ++mt) {
#pragma unroll
      for (int r = 0; r < 16; ++r) st[mt][r] = 0.f;
#pragma unroll
      for (int s = 0; s < NS; ++s) {
        bf16x8 kf = *reinterpret_cast<const bf16x8*>(Ksr + (mt * 32 + l31) * KSTR + kcol0 + s * 16 + hh * 8);
        st[mt] = MFMA(kf, qf[s], st[mt]);
      }
    }
    float mx = -1e30f;
#pragma unroll
    for (int mt = 0; mt < 2; ++mt)
#pragma unroll
      for (int r = 0; r < 16; ++r) {
        float x = st[mt][r];
        if (ALIBI) { x = __builtin_fmaf(-slope2, fabsf(qk0 - (float)(mt * 32 + (r & 3) + 8 * (r >> 2))), x); st[mt][r] = x; }
        mx = fmaxf(mx, x);
      }
    mx = fmaxf(mx, __shfl_xor(mx, 32));
    if (!ALIBI || __builtin_amdgcn_ballot_w64(mx - m_run > -40.f) != 0) {
    const float m_new = fmaxf(m_run, mx);
    const float alpha = fexp2(m_run - m_new);
    m_run = m_new;
    float ls = 0.f;
#pragma unroll
    for (int mt = 0; mt < 2; ++mt)
#pragma unroll
      for (int r = 0; r < 16; ++r) { float pv = fexp2(st[mt][r] - m_new); ls += pv; st[mt][r] = pv; }
    l_run = l_run * alpha + ls;
    if (!ALIBI || __builtin_amdgcn_ballot_w64(alpha != 1.f) != 0) {
#pragma unroll
      for (int dt = 0; dt < 4; ++dt)
#pragma unroll
        for (int r = 0; r < 16; ++r) O[dt][r] *= alpha;
    }
#pragma unroll
    for (int mt = 0; mt < 2; ++mt) {
      bf16x8 pf0 = pack8<0>(st[mt]), pf1 = pack8<1>(st[mt]);
#pragma unroll
      for (int dt = 0; dt < 4; ++dt) {
        bf16x8 v0 = ld_perm(VTr + (dt * 32 + l31) * VSTR + mt * 32 + 0 + 4 * hh);
        O[dt] = MFMA(v0, pf0, O[dt]);
        bf16x8 v1 = ld_perm(VTr + (dt * 32 + l31) * VSTR + mt * 32 + 16 + 4 * hh);
        O[dt] = MFMA(v1, pf1, O[dt]);
      }
    }
    }
    __syncthreads();
  }
  float l = l_run + __shfl_xor(l_run, 32);
  linv = 1.f / l;
}

DI void diff_item(const Params& p, const Grp& G, int l, int gslot, int idx, char* smem) {
  const int nqb = G.T >> 6;
  const int qb = idx % nqb, head = (idx / nqb) & 3, seq = idx / (nqb * 4);
  const int tid = otid(), lane = tid & 63, wave = tid >> 6, hh = lane >> 5, l31 = lane & 31;
  const int ps = wave >> 1, rw = wave & 1;
  const float* lp = p.diff_lambda + l * 256;
  float s1 = wave_sum(lp[lane] * lp[64 + lane]);
  float s2 = wave_sum(lp[128 + lane] * lp[192 + lane]);
  const float lam = __expf(s1) - __expf(s2) + p.lam_init[l];
  const float slope2 = exp2f(-2.f * (float)(head + 1)) * LOG2E;
  const long mrow0 = (long)seq * G.T + qb * 64 + rw * 32;
  const bf16* VT = p.dvT + (long)((seq * 4 + head) * 128) * G.T;
  f32x16 O[4];
  float linv;
  attn_pass<128, 4, true>(p.proj + mrow0 * NIN + C_DQ + head * 128 + ps * 64, NIN,
                          p.proj + (long)seq * G.T * NIN + C_DK + head * 128, NIN,
                          VT, G.T, G.T, qb * 64, slope2, (float)(qb * 64 + rw * 32 + l31), ps * 64,
                          p.knmax + (gslot * 8 + seq) * 8 + head * 2 + ps, O, linv, smem);
  float* xs = reinterpret_cast<float*>(smem) + (rw * 64) * 64 + lane;
  if (ps == 1) {
#pragma unroll
    for (int dt = 0; dt < 4; ++dt)
#pragma unroll
      for (int r = 0; r < 16; ++r) xs[(dt * 16 + r) * 64] = O[dt][r] * linv;
  }
  __syncthreads();
  if (ps == 0) {
    float ss = 0.f;
#pragma unroll
    for (int dt = 0; dt < 4; ++dt)
#pragma unroll
      for (int r = 0; r < 16; ++r) { float o = O[dt][r] * linv - lam * xs[(dt * 16 + r) * 64]; O[dt][r] = o; ss += o * o; }
    ss += __shfl_xor(ss, 32);
    const float rs = rsqrtf(ss * (1.f / 128.f) + EPSN) * (1.f - p.lam_init[l]);
    const long m = mrow0 + l31;
    const float* gn = p.diff_norm_g + l * 128;
#pragma unroll
    for (int dt = 0; dt < 4; ++dt)
#pragma unroll
      for (int rq = 0; rq < 4; ++rq) {
        int dv0 = dt * 32 + 8 * rq + 4 * hh;
        uint2 zz = *reinterpret_cast<const uint2*>(p.proj + m * NIN + C_ZB + head * 128 + dv0);
        float4 g4 = *reinterpret_cast<const float4*>(gn + dv0);
        float y0 = O[dt][4 * rq + 0] * rs * g4.x * bf2f((bf16)(zz.x & 0xffff));
        float y1 = O[dt][4 * rq + 1] * rs * g4.y * bf2f((bf16)(zz.x >> 16));
        float y2 = O[dt][4 * rq + 2] * rs * g4.z * bf2f((bf16)(zz.y & 0xffff));
        float y3 = O[dt][4 * rq + 3] * rs * g4.w * bf2f((bf16)(zz.y >> 16));
        *reinterpret_cast<uint2*>(p.br + m * 1536 + 512 + head * 128 + dv0) = make_uint2(pack2(y0, y1), pack2(y2, y3));
      }
  }
  __syncthreads();
}

DI void cross_item(const Params& p, const Grp& G, int l, int idx, char* smem) {
  const int nqb = G.T >> 7;
  const int qb = idx % nqb, head = (idx / nqb) & 3, seq = idx / (nqb * 4);
  const int tid = otid(), lane = tid & 63, wave = tid >> 6, hh = lane >> 5, l31 = lane & 31;
  const long mrow0 = (long)seq * G.T + qb * 128;
  const int mb = G.mem0 + seq;
  f32x16 O[4];
  float linv;
  attn_pass<128, 8, false>(p.proj + (mrow0 + wave * 32) * NIN + C_CQ + head * 128, NIN,
                        p.kmem + ((long)l * MEMROWS + mb * 256) * 512 + head * 128, 512,
                        p.vmemT + (long)l * (34 * 4 * 128 * 256) + (long)((mb * 4 + head) * 128) * 256, 256,
                        256, 0, 0.f, 0.f, 0, nullptr, O, linv, smem);
  const long m = mrow0 + wave * 32 + l31;
#pragma unroll
  for (int dt = 0; dt < 4; ++dt)
#pragma unroll
    for (int rq = 0; rq < 4; ++rq) {
      int dv0 = dt * 32 + 8 * rq + 4 * hh;
      uint2 zz = *reinterpret_cast<const uint2*>(p.proj + m * NIN + C_ZC + head * 128 + dv0);
      float y0 = O[dt][4 * rq + 0] * linv * bf2f((bf16)(zz.x & 0xffff));
      float y1 = O[dt][4 * rq + 1] * linv * bf2f((bf16)(zz.x >> 16));
      float y2 = O[dt][4 * rq + 2] * linv * bf2f((bf16)(zz.y & 0xffff));
      float y3 = O[dt][4 * rq + 3] * linv * bf2f((bf16)(zz.y >> 16));
      *reinterpret_cast<uint2*>(p.br + m * 1536 + 1024 + head * 128 + dv0) = make_uint2(pack2(y0, y1), pack2(y2, y3));
    }
}

DI void gla_item(const Params& p, const Grp& G, int l, int idx, char* smem) {
  const int seq = idx >> 3, head = (idx >> 1) & 3, dir = idx & 1;
  const int T = G.T, nch = T >> 6;
  bf16* qt = reinterpret_cast<bf16*>(smem);
  bf16* kt = qt + 64 * 72;
  bf16* ktT = kt + 64 * 72;
  bf16* vT = ktT + 64 * 72;
  float* tot = reinterpret_cast<float*>(vT + 128 * 72);
  float* eb = tot + 256;
  const int tid = otid(), lane = tid & 63, wave = tid >> 6, hh = lane >> 5, l31 = lane & 31;
  const int d = tid & 63, g = tid >> 6;
  f32x16 S[2];
#pragma unroll
  for (int dt = 0; dt < 2; ++dt)
#pragma unroll
    for (int r = 0; r < 16; ++r) S[dt][r] = 0.f;
  const bf16* projg = p.proj + (long)seq * T * NIN;
  const float* lag = p.la + (long)seq * T * 512 + dir * 256 + head * 64;
  const bf16* vTg = p.gvT + (long)((seq * 4 + head) * 128) * T;
  float* og = p.glao + (long)dir * MG * 512 + (long)seq * T * 512 + head * 128;
  for (int ci = 0; ci < nch; ++ci) {
    const int c = dir ? nch - 1 - ci : ci, t0 = c * 64;
    float cs[16], qr[16], kr[16];
    uint4 vv0, vv1, vv2, vv3;
#pragma unroll
    for (int i = 0; i < 16; ++i) {
      long t = t0 + 16 * g + i;
      cs[i] = lag[t * 512 + d];
      qr[i] = bf2f(projg[t * NIN + C_GQ + head * 64 + d]);
      kr[i] = bf2f(projg[t * NIN + C_GK + head * 64 + d]);
    }
    {
      const bf16* vp = vTg + (long)(tid >> 3) * T + t0 + (tid & 7) * 8;
      vv0 = *reinterpret_cast<const uint4*>(vp);
      vv1 = *reinterpret_cast<const uint4*>(vp + (long)32 * T);
      vv2 = *reinterpret_cast<const uint4*>(vp + (long)64 * T);
      vv3 = *reinterpret_cast<const uint4*>(vp + (long)96 * T);
    }
    float run = 0.f;
    if (dir == 0) {
#pragma unroll
      for (int i = 0; i < 16; ++i) { run += cs[i]; cs[i] = run; }
    } else {
#pragma unroll
      for (int i = 15; i >= 0; --i) { run += cs[i]; cs[i] = run; }
    }
    tot[g * 64 + d] = run;
    __syncthreads();
    float pre = 0.f, total = 0.f;
#pragma unroll
    for (int gg = 0; gg < 4; ++gg) {
      float tv = tot[gg * 64 + d];
      total += tv;
      bool inc = dir == 0 ? (gg < g) : (gg > g);
      if (inc) pre += tv;
    }
    unsigned kp[8];
#pragma unroll
    for (int i = 0; i < 16; i += 2) {
      float b0 = pre + cs[i], b1 = pre + cs[i + 1];
      float q0 = qr[i] * __expf(b0), q1 = qr[i + 1] * __expf(b1);
      float k0v = kr[i] * __expf(-b0), k1v = kr[i + 1] * __expf(-b1);
      unsigned qp = pack2(q0, q1), kpk = pack2(k0v, k1v);
      qt[(16 * g + i) * 72 + d] = (bf16)(qp & 0xffff);
      qt[(16 * g + i + 1) * 72 + d] = (bf16)(qp >> 16);
      kt[(16 * g + i) * 72 + d] = (bf16)(kpk & 0xffff);
      kt[(16 * g + i + 1) * 72 + d] = (bf16)(kpk >> 16);
      kp[i >> 1] = kpk;
    }
    *reinterpret_cast<uint4*>(ktT + d * 72 + 16 * g) = make_uint4(kp[0], kp[1], kp[2], kp[3]);
    *reinterpret_cast<uint4*>(ktT + d * 72 + 16 * g + 8) = make_uint4(kp[4], kp[5], kp[6], kp[7]);
    if (g == 0) eb[d] = __expf(total);
    {
      bf16* vw = vT + (tid >> 3) * 72 + (tid & 7) * 8;
      *reinterpret_cast<uint4*>(vw) = vv0;
      *reinterpret_cast<uint4*>(vw + 32 * 72) = vv1;
      *reinterpret_cast<uint4*>(vw + 64 * 72) = vv2;
      *reinterpret_cast<uint4*>(vw + 96 * 72) = vv3;
    }
    __syncthreads();
    f32x16 AT[2][2];
#pragma unroll
    for (int st = 0; st < 2; ++st)
#pragma unroll
      for (int tt = 0; tt < 2; ++tt) {
#pragma unroll
        for (int r = 0; r < 16; ++r) AT[st][tt][r] = 0.f;
#pragma unroll
        for (int ks = 0; ks < 4; ++ks) {
          bf16x8 a = *reinterpret_cast<const bf16x8*>(kt + (st * 32 + l31) * 72 + ks * 16 + hh * 8);
          bf16x8 b = *reinterpret_cast<const bf16x8*>(qt + (tt * 32 + l31) * 72 + ks * 16 + hh * 8);
          AT[st][tt] = MFMA(a, b, AT[st][tt]);
        }
#pragma unroll
        for (int r = 0; r < 16; ++r) {
          int s = st * 32 + crow(r, hh), t = tt * 32 + l31;
          bool keep = dir == 0 ? (s <= t) : (s >= t);
          if (!keep) AT[st][tt][r] = 0.f;
        }
      }
    f32x16 o[2];
#pragma unroll
    for (int tt = 0; tt < 2; ++tt) {
#pragma unroll
      for (int r = 0; r < 16; ++r) o[tt][r] = 0.f;
#pragma unroll
      for (int st = 0; st < 2; ++st) {
        bf16x8 pa0 = pack8<0>(AT[st][tt]), pa1 = pack8<1>(AT[st][tt]);
        bf16x8 vb0 = ld_perm(vT + (wave * 32 + l31) * 72 + st * 32 + 0 + 4 * hh);
        bf16x8 vb1 = ld_perm(vT + (wave * 32 + l31) * 72 + st * 32 + 16 + 4 * hh);
        o[tt] = MFMA(pa0, vb0, o[tt]);
        o[tt] = MFMA(pa1, vb1, o[tt]);
      }
#pragma unroll
      for (int dt = 0; dt < 2; ++dt) {
        bf16x8 sb0 = pack8<0>(S[dt]), sb1 = pack8<1>(S[dt]);
        bf16x8 qa0 = ld_perm(qt + (tt * 32 + l31) * 72 + dt * 32 + 0 + 4 * hh);
        bf16x8 qa1 = ld_perm(qt + (tt * 32 + l31) * 72 + dt * 32 + 16 + 4 * hh);
        o[tt] = MFMA(qa0, sb0, o[tt]);
        o[tt] = MFMA(qa1, sb1, o[tt]);
      }
#pragma unroll
      for (int r = 0; r < 16; ++r) {
        long t = t0 + tt * 32 + crow(r, hh);
        og[t * 512 + wave * 32 + l31] = o[tt][r];
      }
    }
#pragma unroll
    for (int dt = 0; dt < 2; ++dt) {
#pragma unroll
      for (int ks = 0; ks < 4; ++ks) {
        bf16x8 a = *reinterpret_cast<const bf16x8*>(ktT + (dt * 32 + l31) * 72 + ks * 16 + hh * 8);
        bf16x8 b = *reinterpret_cast<const bf16x8*>(vT + (wave * 32 + l31) * 72 + ks * 16 + hh * 8);
        S[dt] = MFMA(a, b, S[dt]);
      }
#pragma unroll
      for (int r = 0; r < 16; ++r) S[dt][r] *= eb[dt * 32 + crow(r, hh)];
    }
    __syncthreads();
  }
}

DI void gla_combine_row(const Params& p, int l, long m, int lane) {
  const float* a = p.glao + m * 512 + lane * 8;
  const float* b = a + (long)MG * 512;
  float4 a0 = reinterpret_cast<const float4*>(a)[0], a1 = reinterpret_cast<const float4*>(a)[1];
  float4 b0 = reinterpret_cast<const float4*>(b)[0], b1 = reinterpret_cast<const float4*>(b)[1];
  float o[8] = {a0.x + b0.x, a0.y + b0.y, a0.z + b0.z, a0.w + b0.w, a1.x + b1.x, a1.y + b1.y, a1.z + b1.z, a1.w + b1.w};
  float ss = 0.f;
#pragma unroll
  for (int i = 0; i < 8; ++i) ss += o[i] * o[i];
#pragma unroll
  for (int off = 8; off >= 1; off >>= 1) ss += __shfl_xor(ss, off);
  float rs = rsqrtf(ss * (1.f / 128.f) + EPSN);
  const float* gn = p.gla_norm_g + l * 128 + (lane & 15) * 8;
  uint4 zz = *reinterpret_cast<const uint4*>(p.proj + m * NIN + C_ZA + lane * 8);
  unsigned zw[4] = {zz.x, zz.y, zz.z, zz.w};
  unsigned ow[4];
#pragma unroll
  for (int e = 0; e < 4; ++e) {
    float y0 = o[2 * e] * rs * gn[2 * e] * bf2f((bf16)(zw[e] & 0xffff));
    float y1 = o[2 * e + 1] * rs * gn[2 * e + 1] * bf2f((bf16)(zw[e] >> 16));
    ow[e] = pack2(y0, y1);
  }
  *reinterpret_cast<uint4*>(p.br + m * 1536 + lane * 8) = make_uint4(ow[0], ow[1], ow[2], ow[3]);
}

DI void gbr_tile(const Params& p, int l, int tile, char* smem) {
  const int mt = tile >> 3, nt = tile & 7, m0 = mt * 128, n0 = nt * 128;
  f32x16 sum[2][2], acc[2][2];
  zero_acc(sum);
  zero_acc(acc);
  const bf16* A = p.Wb + ((long)l * 1024 + n0) * 1536;
  const bf16* B = p.br + (long)m0 * 1536;
  const int lda = 1536, ldb = 1536, K = 1536;
  bf16* As = reinterpret_cast<bf16*>(smem);
  const int tid = otid(), lane = tid & 63, wave = tid >> 6, wm = wave >> 1, wn = wave & 1, hh = lane >> 5, l31 = lane & 31;
  uint4 pa0, pa1, pa2, pa3, pb0, pb1, pb2, pb3;
  const int lrow = tid >> 3, lc = tid & 7;
  const bf16* Ap = A + (long)lrow * lda + lc * 8;
  const bf16* Bp = B + (long)lrow * ldb + lc * 8;
  bf16* Asw = As + lrow * GSTR + lc * 8;
  GEMM_LDG(p, 0)
  GEMM_STS(p, 0)
  GEMM_LDG(p, 64)
  __syncthreads();
  uint2 g00, g01, g02, g03, g10, g11, g12, g13, g20, g21, g22, g23, g30, g31, g32, g33;
#define GBR_GLD(i, j, rq, dstv) dstv = *reinterpret_cast<const uint2*>(p.proj + (long)(m0 + wn * 64 + (j) * 32 + l31) * NIN + C_GATE + bi_ * 1024 + n0 + wm * 64 + (i) * 32 + 8 * (rq) + 4 * hh);
  for (int k0 = 0; k0 < K; k0 += 128) {
    if ((k0 & 511) == 0) {
      const int bi_ = k0 >> 9;
      GBR_GLD(0, 0, 0, g00) GBR_GLD(0, 0, 1, g01) GBR_GLD(0, 0, 2, g02) GBR_GLD(0, 0, 3, g03)
      GBR_GLD(0, 1, 0, g10) GBR_GLD(0, 1, 1, g11) GBR_GLD(0, 1, 2, g12) GBR_GLD(0, 1, 3, g13)
      GBR_GLD(1, 0, 0, g20) GBR_GLD(1, 0, 1, g21) GBR_GLD(1, 0, 2, g22) GBR_GLD(1, 0, 3, g23)
      GBR_GLD(1, 1, 0, g30) GBR_GLD(1, 1, 1, g31) GBR_GLD(1, 1, 2, g32) GBR_GLD(1, 1, 3, g33)
    }
    GEMM_STS(p, GBUF)
    if (k0 + 128 < K) { GEMM_LDG(p, k0 + 128) }
    GEMM_COMPUTE(0)
    __syncthreads();
    if (k0 + 128 < K) { GEMM_STS(p, 0) }
    if (k0 + 192 < K) { GEMM_LDG(p, k0 + 192) }
    GEMM_COMPUTE(GBUF)
    __syncthreads();
    if (((k0 + 128) & 511) == 0) {
#pragma unroll
      for (int i = 0; i < 2; ++i)
#pragma unroll
        for (int j = 0; j < 2; ++j)
#pragma unroll
          for (int rq = 0; rq < 4; ++rq) {
            const int q = i * 2 + j;
            const uint2 gg = q == 0 ? (rq == 0 ? g00 : rq == 1 ? g01 : rq == 2 ? g02 : g03)
                           : q == 1 ? (rq == 0 ? g10 : rq == 1 ? g11 : rq == 2 ? g12 : g13)
                           : q == 2 ? (rq == 0 ? g20 : rq == 1 ? g21 : rq == 2 ? g22 : g23)
                                    : (rq == 0 ? g30 : rq == 1 ? g31 : rq == 2 ? g32 : g33);
            sum[i][j][4 * rq + 0] += bf2f((bf16)(gg.x & 0xffff)) * acc[i][j][4 * rq + 0];
            sum[i][j][4 * rq + 1] += bf2f((bf16)(gg.x >> 16)) * acc[i][j][4 * rq + 1];
            sum[i][j][4 * rq + 2] += bf2f((bf16)(gg.y & 0xffff)) * acc[i][j][4 * rq + 2];
            sum[i][j][4 * rq + 3] += bf2f((bf16)(gg.y >> 16)) * acc[i][j][4 * rq + 3];
            acc[i][j][4 * rq + 0] = 0.f; acc[i][j][4 * rq + 1] = 0.f; acc[i][j][4 * rq + 2] = 0.f; acc[i][j][4 * rq + 3] = 0.f;
          }
    }
  }
  epi_pack_store<0>(sum, p.merged + (long)m0 * 1024 + n0, 1024, smem);
}

DI void gout_tile(const Params& p, int l, int tile, const float* __restrict__ xsrc, float* __restrict__ xdst, char* smem) {
  const int mt = tile >> 3, nt = tile & 7, m0 = mt * 128, n0 = nt * 128;
  const int tid = otid(), lane = tid & 63, wave = tid >> 6, wm = wave >> 1, wn = wave & 1, hh = lane >> 5, l31 = lane & 31;
  f32x16 acc[2][2], xa[2], xb[2];
  zero_acc(acc);
  const float* xs0 = xsrc + (long)(m0 + wm * 64 + 4 * hh) * 1024 + n0 + wn * 64 + l31;
  float* xd0 = xdst + (long)(m0 + wm * 64 + 4 * hh) * 1024 + n0 + wn * 64 + l31;
#pragma unroll
  for (int j = 0; j < 2; ++j)
#pragma unroll
    for (int r = 0; r < 16; ++r) xa[j][r] = xs0[(long)((r & 3) + 8 * (r >> 2)) * 1024 + j * 32];
  gemm_mainloop1(p.merged + (long)m0 * 1024, 1024, p.Wout + ((long)l * 1024 + n0) * 1024, 1024, 1024, acc, smem);
#pragma unroll
  for (int j = 0; j < 2; ++j)
#pragma unroll
    for (int r = 0; r < 16; ++r) xb[j][r] = xs0[(long)(32 + (r & 3) + 8 * (r >> 2)) * 1024 + j * 32];
#pragma unroll
  for (int j = 0; j < 2; ++j)
#pragma unroll
    for (int r = 0; r < 16; ++r) xd0[(long)((r & 3) + 8 * (r >> 2)) * 1024 + j * 32] = xa[j][r] + acc[0][j][r];
#pragma unroll
  for (int j = 0; j < 2; ++j)
#pragma unroll
    for (int r = 0; r < 16; ++r) xd0[(long)(32 + (r & 3) + 8 * (r >> 2)) * 1024 + j * 32] = xb[j][r] + acc[1][j][r];
}

#define XB_TMO      128
#define XB_XCNT(j)  (256  + 64 * (j))
#define XB_XSUB(j)  (1280 + 64 * (j))
#define XB_XGEN(j)  (2304 + 64 * (j))
#define XB_TOP      3328
#define XB_TOPGEN   3392
#define XT_SUB(j)   (3584 + 64 * (j))
#define XT_GEN(j)   (4608 + 64 * (j))
#define XCD_BAR_WORDS 5632
#define XB_SPIN_CAP (1u << 22)
#define LAS __attribute__((address_space(3)))
DI unsigned xb_ld(unsigned* p)              { return __hip_atomic_load(p, __ATOMIC_RELAXED, __HIP_MEMORY_SCOPE_AGENT); }
DI unsigned xb_add(unsigned* p, unsigned v) { return __hip_atomic_fetch_add(p, v, __ATOMIC_RELAXED, __HIP_MEMORY_SCOPE_AGENT); }
DI unsigned xb_xcc_id() { return (unsigned)__builtin_amdgcn_s_getreg((3 << 11) | 20) & 0xFu; }
#define XB_SPIN(cond, bar) do { unsigned _sp = 0; while (cond) { __builtin_amdgcn_s_sleep(4); \
    if ((++_sp & 255u) == 0u) { if (xb_ld(&(bar)[XB_TMO])) break; if (_sp > XB_SPIN_CAP) { atomicAdd(&(bar)[XB_TMO], 1u); break; } } } } while (0)
struct XcdBarrier { unsigned* bar; unsigned x; volatile LAS unsigned* st; };
DI XcdBarrier xcd_barrier_post(unsigned* bar, volatile LAS unsigned* st) {
  XcdBarrier b; b.bar = bar; b.x = xb_xcc_id(); b.st = st;
  if (threadIdx.x == 0) (void)xb_add(&bar[XB_XCNT(b.x)], 1u);
  return b;
}
DI void xcd_barrier_complete(unsigned* bar, unsigned x, unsigned& nloc, unsigned& nx) {
  const unsigned G = gridDim.x * gridDim.y * gridDim.z;
  unsigned sum, cnt, mine, sp = 0u;
  for (;;) {
    sum = 0u; cnt = 0u; mine = 0u;
#pragma unroll
    for (unsigned j = 0; j < 16; ++j) { const unsigned c = xb_ld(&bar[XB_XCNT(j)]); sum += c; cnt += (c > 0u) ? 1u : 0u; mine = (j == x) ? c : mine; }
    if (sum == G) break;
    __builtin_amdgcn_s_sleep(1);
    if ((++sp & 255u) == 0u) { if (xb_ld(&bar[XB_TMO])) break; if (sp > XB_SPIN_CAP) { atomicAdd(&bar[XB_TMO], 1u); break; } }
  }
  nloc = mine > 0u ? mine : 1u; nx = cnt > 0u ? cnt : 1u;
}
DI void xcd_barrier(const XcdBarrier& b) {
  asm volatile("s_waitcnt vmcnt(0)" ::: "memory");
  __syncthreads();
  if (threadIdx.x == 0) {
    unsigned* bar = b.bar;
    __builtin_amdgcn_s_waitcnt(0);
    unsigned nloc = b.st[0], nx = b.st[1];
    if (nloc == 0u) { xcd_barrier_complete(bar, b.x, nloc, nx); b.st[0] = nloc; b.st[1] = nx; }
    const unsigned old = xb_add(&bar[XB_XSUB(b.x)], 1u);
    const unsigned gen = old / nloc;
    if (old + 1u == (gen + 1u) * nloc) {
      __builtin_amdgcn_fence(__ATOMIC_RELEASE, "agent");
      asm volatile("s_waitcnt vmcnt(0)" ::: "memory");
      const unsigned og = xb_add(&bar[XB_TOP], 1u);
      const unsigned tg = og / nx;
      if (og + 1u == (tg + 1u) * nx) xb_add(&bar[XB_TOPGEN], 1u);
      else XB_SPIN(xb_ld(&bar[XB_TOPGEN]) == tg, bar);
      __builtin_amdgcn_fence(__ATOMIC_ACQUIRE, "agent");
      xb_add(&bar[XB_XGEN(b.x)], 1u);
      asm volatile("s_waitcnt vmcnt(0)" ::: "memory");
    } else {
      XB_SPIN(xb_ld(&bar[XB_XGEN(b.x)]) == gen, bar);
      __builtin_amdgcn_fence(__ATOMIC_ACQUIRE, "agent");
      asm volatile("s_waitcnt vmcnt(0)" ::: "memory");
    }
  }
  __syncthreads();
}

DI void team_barrier(const XcdBarrier& b) {
  asm volatile("s_waitcnt vmcnt(0)" ::: "memory");
  __syncthreads();
  if (threadIdx.x == 0) {
    unsigned* bar = b.bar;
    __builtin_amdgcn_s_waitcnt(0);
    const unsigned nloc = b.st[0];
    const unsigned old = xb_add(&bar[XT_SUB(b.x)], 1u);
    const unsigned gen = old / nloc;
    if (old + 1u == (gen + 1u) * nloc) {
      __builtin_amdgcn_fence(__ATOMIC_RELEASE, "agent");
      asm volatile("s_waitcnt vmcnt(0)" ::: "memory");
      __builtin_amdgcn_fence(__ATOMIC_ACQUIRE, "agent");
      xb_add(&bar[XT_GEN(b.x)], 1u);
      asm volatile("s_waitcnt vmcnt(0)" ::: "memory");
    } else {
      XB_SPIN(xb_ld(&bar[XT_GEN(b.x)]) == gen, bar);
      __builtin_amdgcn_fence(__ATOMIC_ACQUIRE, "agent");
      asm volatile("s_waitcnt vmcnt(0)" ::: "memory");
    }
  }
  __syncthreads();
}

__global__ void __launch_bounds__(256, 2) mega(Params p) {
  extern __shared__ __attribute__((aligned(16))) char smem[];
  __shared__ int s_item;
  __shared__ uint4 xb_words;
  cg::grid_group grid = cg::this_grid();
  if (threadIdx.x == 0) xb_words = make_uint4(0u, 0u, 0u, 0u);
  __syncthreads();
  const int nblk = gridDim.x, bid = blockIdx.x;
  const int nwave = nblk * 4;
#define ROW_IDS const int tid = otid(), lane = tid & 63, gwave = bid * 4 + (tid >> 6);

  for (int t = bid; t < PREP_L0; t += nblk) prep_tile(p, prep_l0_tile(t), smem);
  {
    ROW_IDS
    if (bid == 0) { for (int i = tid; i < 1024; i += 256) p.counters[i] = 0; for (int i = tid; i < 2048; i += 256) p.knmax[i] = 0; for (int i = tid; i < XCD_BAR_WORDS; i += 256) p.bar[i] = 0u; }
    for (int r = gwave; r < MEMROWS; r += nwave) {
      const float* src = r < 8192 ? p.mem_prompt + (long)r * 1024 : p.mem_sample + (long)(r - 8192) * 1024;
      rownorm_bf16_row(src, p.memn + (long)r * 1024, lane);
    }
    for (int r = gwave; r < MG; r += nwave) rownorm_bf16_row(p.x_prompt + (long)r * 1024, p.xn + (long)r * 1024, lane);
  }
  grid.sync();
  XcdBarrier xb = xcd_barrier_post(p.bar, (volatile LAS unsigned*)&xb_words);
  __shared__ int s_xm[4];
  {
    const int x = (int)xb_xcc_id();
    if (threadIdx.x == 0) s_xm[1] = atomicAdd(&p.counters[960 + x], 1);
    xcd_barrier(xb);
    if (threadIdx.x == 0) {
      int nx = 0, ok = 1, mine = 0;
      for (int j = 0; j < 16; ++j) {
        int c = __hip_atomic_load(&p.counters[960 + j], __ATOMIC_RELAXED, __HIP_MEMORY_SCOPE_AGENT);
        if (c > 0) ++nx;
        if (j < 8 && c * 8 != nblk) ok = 0;
        if (j >= 8 && c != 0) ok = 0;
        if (j == x) mine = c;
      }
      s_xm[0] = x; s_xm[2] = mine; s_xm[3] = (ok && nx == 8) ? 1 : 0;
    }
    __syncthreads();
  }
  const int xcd = s_xm[0], xrank = s_xm[1], xnl = s_xm[2];
  const bool xaware = s_xm[3] != 0;

  for (int g = 0; g < NGROUP; ++g) {
    const Grp G = get_grp(g);
    const float* xin = g < 4 ? p.x_prompt + (long)g * MG * 1024 : p.x_sample;
    float* xout = p.out + (long)G.tok0 * 1024;
    for (int l = 0; l < NLAYER; ++l) {
      {
        const int kv_lo = (g == 0 && l == 0) ? 0 : 68, kv_hi = (g == 0 && l == 0) ? 68 : ((g == 0 && l == 1) ? 272 : 68);
        const int extra = (kv_hi - kv_lo) * 8;
        const int ntile = 128 * 64 + extra;
        if (xaware) {
          for (int i = xrank; i < 192; i += xnl) gin_tile(p, G, l, g * NLAYER + l, (xcd + 8 * (i / 12)) * 64 + (i % 12), smem);
          for (int i = kv_lo + xrank; i < kv_hi; i += xnl) gkv_tile(p, i * 8 + xcd, smem);
          xcd_barrier(xb);
          {
            const int n_gla = G.nseq == 8 ? 8 : 2, total = n_gla + 832;
            int* ctr = p.counters + 512 + ((g * NLAYER + l) * 8 + xcd);
            while (true) {
              if (otid() == 0) s_item = atomicAdd(ctr, 1);
              __syncthreads();
              const int item = s_item;
              __syncthreads();
              if (item >= total) break;
              if (item < n_gla) {
                const int ph = G.nseq == 8 ? xcd * 4 + (item >> 1) : xcd;
                gla_item(p, G, l, ph * 2 + (item & 1), smem);
              } else {
                const int j = item - n_gla;
                int r, jj, cnt, t1;
                if (j < 384) { r = j / 96; jj = j % 96; cnt = 6; t1 = 2; }
                else { r = 4 + (j - 384) / 112; jj = (j - 384) % 112; cnt = 7; t1 = 1; }
                const int half = jj / (cnt * 8), rem = jj % (cnt * 8);
                const int nt = r + 8 * (t1 + (rem >> 3));
                const int mt = ((((xcd - nt) & 7) + 8 * half) << 3) + (rem & 7);
                gin_tile(p, G, l, g * NLAYER + l, mt * 64 + nt, smem);
              }
            }
          }
        } else {
          for (int t = bid; t < ntile; t += nblk) {
            if (t < 128 * 64) gin_tile(p, G, l, g * NLAYER + l, t, smem);
            else gkv_tile(p, kv_lo * 8 + (t - 128 * 64), smem);
          }
        }
      }
      xcd_barrier(xb);
      {
        const int nqb = G.T >> 7;
        if (xaware) {
          const int nqd = nqb * 2;
          const bool prm = G.nseq == 8;
          const int n_gla = 0, n_dif = prm ? 4 * nqd : nqd, n_att = prm ? 4 * nqb : nqb;
          const int n_cmb = 64;
          const int n_prep = (g == 0 && l == 0) ? PREP_DEF / 8 : 0;
          const int total = n_gla + n_dif + n_att + n_cmb + n_prep;
          const int xs_ = xcd >> 2, xh_ = xcd & 3;
          int* ctr = p.counters + ((g * NLAYER + l) * 8 + xcd);
          while (true) {
            if (otid() == 0) s_item = atomicAdd(ctr, 1);
            __syncthreads();
            const int item = s_item;
            __syncthreads();
            if (item >= total) break;
            if (item < n_gla) {
              const int ph = prm ? xcd * 4 + (item >> 1) : xcd;
              gla_item(p, G, l, ph * 2 + (item & 1), smem);
            } else if (item < n_gla + n_dif) {
              const int j = item - n_gla;
              int ph, qb;
              if (prm) { ph = xcd * 4 + (3 - j / nqd); qb = j % nqd; }
              else {
                const int half = nqd >> 1, hi = xh_ > 3 - xh_ ? xh_ : 3 - xh_, lo = 3 - hi;
                const int hd = j < half ? hi : lo, jj = j < half ? j : j - half;
                ph = xs_ * 4 + hd; qb = 2 * jj + (hd == xh_ ? 0 : 1);
              }
              diff_item(p, G, l, g * NLAYER + l, ph * nqd + qb, smem);
            } else if (item < n_gla + n_dif + n_att) {
              const int j = item - n_gla - n_dif;
              const int ph = prm ? xcd * 4 + j / nqb : xcd;
              cross_item(p, G, l, ph * nqb + (j % nqb), smem);
            } else if (item < n_gla + n_dif + n_att + n_cmb) {
              const int j = item - n_gla - n_dif - n_att;
              const int tid = otid(), lane = tid & 63, wave = tid >> 6;
#pragma unroll 4
              for (int i = 0; i < 8; ++i) gla_combine_row(p, l, (long)xcd * 2048 + j * 32 + wave * 8 + i, lane);
            } else {
              prep_tile(p, prep_def_tile(xcd + 8 * (item - n_gla - n_dif - n_att - n_cmb)), smem);
            }
          }
        } else {
          const int n_gla = G.nseq * 8, n_dif = G.nseq * 4 * nqb * 2, n_att = G.nseq * 4 * nqb;
          const int n_prep = (g == 0 && l == 0) ? PREP_DEF : 0;
          const int total = n_gla + n_dif + n_att + n_prep;
          int* ctr = p.counters + 400 + (g * NLAYER + l);
          while (true) {
            if (otid() == 0) s_item = atomicAdd(ctr, 1);
            __syncthreads();
            const int item = s_item;
            __syncthreads();
            if (item >= total) break;
            if (item < n_gla) gla_item(p, G, l, item, smem);
            else if (item < n_gla + n_dif) diff_item(p, G, l, g * NLAYER + l, item - n_gla, smem);
            else if (item < n_gla + n_dif + n_att) cross_item(p, G, l, item - n_gla - n_dif, smem);
            else prep_tile(p, prep_def_tile(item - n_gla - n_dif - n_att), smem);
          }
        }
      }
      xcd_barrier(xb);
      if (!xaware) {
        ROW_IDS
        for (int r = gwave; r < MG; r += nwave) gla_combine_row(p, l, r, lane);
      }
      if (!xaware) xcd_barrier(xb);
      if (xaware) { for (int i = xrank; i < 128; i += xnl) gbr_tile(p, l, (xcd + 8 * (i >> 3)) * 8 + (i & 7), smem); }
      else { for (int t = bid; t < 128 * 8; t += nblk) gbr_tile(p, l, t, smem); }
      const bool team = xaware && xnl == 64;
      if (team) team_barrier(xb); else xcd_barrier(xb);
      {
        const float* xs = l == 0 ? xin : xout;
        if (xaware) { for (int i = xrank; i < 128; i += xnl) gout_tile(p, l, (xcd + 8 * (i >> 3)) * 8 + (i & 7), xs, xout, smem); }
        else { for (int t = bid; t < 128 * 8; t += nblk) gout_tile(p, l, t, xs, xout, smem); }
      }
      const bool teamn = team && l < NLAYER - 1;
      if (teamn) team_barrier(xb); else xcd_barrier(xb);
      ROW_IDS
      if (l < NLAYER - 1) {
        if (teamn) {
          const int wv = xrank * 4 + (tid >> 6);
#pragma unroll 1
          for (int q = 0; q < 8; q += 4) {
            const int i0 = wv + 256 * q;
            const long r0 = (long)(xcd + 8 * (i0 >> 7)) * 128 + (i0 & 127);
            rownorm_bf16_rows4(xout, p.xn, r0, 2 * 8 * 128, lane);
          }
        } else {
          int r = gwave;
          for (; r + 3 * nwave < MG; r += 4 * nwave) rownorm_bf16_rows4(xout, p.xn, r, nwave, lane);
          for (; r < MG; r += nwave) rownorm_bf16_row(xout + (long)r * 1024, p.xn + (long)r * 1024, lane);
        }
      } else {
        for (int r = gwave; r < MG; r += nwave) rownorm_final_row(xout + (long)r * 1024, p.final_g, lane);
        if (g + 1 < NGROUP) {
          const float* xn_in = (g + 1) < 4 ? p.x_prompt + (long)(g + 1) * MG * 1024 : p.x_sample;
          int r = gwave;
          for (; r + 3 * nwave < MG; r += 4 * nwave) rownorm_bf16_rows4(xn_in, p.xn, r, nwave, lane);
          for (; r < MG; r += nwave) rownorm_bf16_row(xn_in + (long)r * 1024, p.xn + (long)r * 1024, lane);
        }
      }
      if (teamn) team_barrier(xb); else xcd_barrier(xb);
    }
  }
}

extern "C" void kernel_launch(void* const* d_in, const int* in_sizes, int n_in, void* d_out, int out_size,
                              void* d_ws, size_t ws_size, hipStream_t stream) {
  static int grid_blocks = 0;
  if (!grid_blocks) {
    int dev = 0, cus = 0, per_cu = 0;
    hipGetDevice(&dev);
    hipDeviceGetAttribute(&cus, hipDeviceAttributeMultiprocessorCount, dev);
    hipFuncSetAttribute((const void*)mega, hipFuncAttributeMaxDynamicSharedMemorySize, SMEM_BYTES);
    hipOccupancyMaxActiveBlocksPerMultiprocessor(&per_cu, mega, 256, SMEM_BYTES);
    if (per_cu > 2) per_cu = 2;
    if (per_cu < 1) per_cu = 1;
    grid_blocks = cus * per_cu;
  }
  Params p{};
  p.x_prompt = (const float*)d_in[0]; p.x_sample = (const float*)d_in[1];
  p.mem_prompt = (const float*)d_in[2]; p.mem_sample = (const float*)d_in[3];
  p.norm_g = (const float*)d_in[4]; p.w_in = (const float*)d_in[5]; p.w2 = (const float*)d_in[6];
  p.b2 = (const float*)d_in[7]; p.gla_norm_g = (const float*)d_in[8]; p.diff_lambda = (const float*)d_in[9];
  p.diff_norm_g = (const float*)d_in[10]; p.mem_norm_g = (const float*)d_in[11]; p.w_mem_kv = (const float*)d_in[12];
  p.w_branch = (const float*)d_in[13]; p.w_out = (const float*)d_in[14]; p.final_g = (const float*)d_in[15];
  p.out = (float*)d_out;
  char* w = (char*)d_ws;
  size_t off = 0;
  auto take = [&](size_t bytes) { char* r = w + off; off += (bytes + 255) & ~(size_t)255; return r; };
  p.Win = (bf16*)take((size_t)NLAYER * NIN * 1024 * 2);
  p.Wkv = (bf16*)take((size_t)NLAYER * 1024 * 1024 * 2);
  p.Wb = (bf16*)take((size_t)NLAYER * 3 * 1024 * 512 * 2);
  p.Wout = (bf16*)take((size_t)NLAYER * 1024 * 1024 * 2);
  p.memn = (bf16*)take((size_t)MEMROWS * 1024 * 2);
  p.kmem = (bf16*)take((size_t)NLAYER * MEMROWS * 512 * 2);
  p.vmemT = (bf16*)take((size_t)NLAYER * MEMROWS * 512 * 2);
  p.xn = (bf16*)take((size_t)MG * 1024 * 2);
  p.proj = (bf16*)take((size_t)MG * NIN * 2);
  p.dvT = (bf16*)take((size_t)MG * 512 * 2);
  p.gvT = (bf16*)take((size_t)MG * 512 * 2);
  p.br = (bf16*)take((size_t)MG * 1536 * 2);
  p.merged = (bf16*)take((size_t)MG * 1024 * 2);
  p.la = (float*)take((size_t)MG * 512 * 4);
  p.glao = (float*)take((size_t)2 * MG * 512 * 4);
  p.park = (float*)take((size_t)grid_blocks * 64 * 256 * 4);
  p.counters = (int*)take(4096);
  p.bar = (unsigned*)take(XCD_BAR_WORDS * 4);
  p.knmax = (int*)take(2048 * 4);
  p.pad_ptr = p.knmax;
  for (int l = 0; l < NLAYER; ++l) p.lam_init[l] = (float)(0.8 - 0.6 * exp(-0.3 * (double)l));
  if (off > ws_size) fprintf(stderr, "workspace too small: need %zu have %zu\n", off, ws_size);
  void* args[] = {&p};
  hipError_t e = hipLaunchCooperativeKernel((void*)mega, dim3(grid_blocks), dim3(256), args, SMEM_BYTES, stream);
  if (e != hipSuccess) fprintf(stderr, "cooperative launch failed: %s (grid %d)\n", hipGetErrorString(e), grid_blocks);
}
```

```cpp
#include <hip/hip_runtime.h>
#include <hip/hip_cooperative_groups.h>
#include <cstdio>
#include <cmath>
namespace cg = cooperative_groups;

typedef unsigned short bf16;
using bf16x8 = __attribute__((ext_vector_type(8))) short;
using s16x4  = __attribute__((ext_vector_type(4))) short;
using f32x16 = __attribute__((ext_vector_type(16))) float;
typedef __bf16 v2bf __attribute__((ext_vector_type(2)));
#define DI __device__ __forceinline__
#define MFMA(a, b, c) __builtin_amdgcn_mfma_f32_32x32x16_bf16((a), (b), (c), 0, 0, 0)

constexpr int DM = 1024;
constexpr int NIN = 8192;
constexpr int MG = 16384;
constexpr int NGROUP = 5;
constexpr int NLAYER = 4;
constexpr int WIN_COLS = 7712;
constexpr int MEMROWS = 34 * 256;
constexpr int C_GQ = 0, C_GK = 256, C_GV = 512, C_LA = 1024, C_ZA = 1536, C_DQ = 2048, C_DK = 2560,
              C_DV = 3072, C_ZB = 3584, C_CQ = 4096, C_ZC = 4608, C_GATE = 5120;
constexpr float LOG2E = 1.4426950408889634f;
constexpr float EPSN = 1e-6f;
constexpr int SMEM_BYTES = 73728;

struct Params {
  const float *x_prompt, *x_sample, *mem_prompt, *mem_sample, *norm_g, *w_in, *w2, *b2, *gla_norm_g,
      *diff_lambda, *diff_norm_g, *mem_norm_g, *w_mem_kv, *w_branch, *w_out, *final_g;
  float* out;
  bf16 *Win, *Wkv, *Wb, *Wout, *memn, *kmem, *vmemT, *xn, *proj, *dvT, *gvT, *br, *merged;
  float *la, *glao, *park;
  int* counters;
  unsigned* bar;
  int* knmax;
  int* pad_ptr;
  float lam_init[4];
};

struct Grp { int nseq, T, tok0, mem0; };
DI Grp get_grp(int g) {
  Grp G;
  if (g < 4) { G.nseq = 8; G.T = 2048; G.tok0 = g * MG; G.mem0 = g * 8; }
  else { G.nseq = 2; G.T = 8192; G.tok0 = 65536; G.mem0 = 32; }
  return G;
}

DI int otid() { int t = threadIdx.x; asm volatile("" : "+v"(t)); return t; }
DI float bf2f(bf16 b) { return __uint_as_float(((unsigned)b) << 16); }
DI unsigned pack2(float a, float b) { v2bf v = {(__bf16)a, (__bf16)b}; return __builtin_bit_cast(unsigned, v); }
DI bf16 f2bf(float a) { return (bf16)(pack2(a, 0.f) & 0xffffu); }
DI int crow(int r, int hh) { return (r & 3) + 8 * (r >> 2) + 4 * hh; }
DI float fexp2(float x) { return __builtin_amdgcn_exp2f(x); }
DI float sigmf(float x) { return __builtin_amdgcn_rcpf(1.f + __builtin_amdgcn_exp2f(-LOG2E * x)); }
DI float siluf(float x) { return x * sigmf(x); }
DI float logsigf(float x) { return fminf(x, 0.f) - 0.6931471805599453f * __builtin_amdgcn_logf(1.f + __builtin_amdgcn_exp2f(-LOG2E * fabsf(x))); }

template <int S>
DI bf16x8 pack8(const f32x16& x) {
  unsigned p0 = pack2(x[8 * S + 0], x[8 * S + 1]);
  unsigned p1 = pack2(x[8 * S + 2], x[8 * S + 3]);
  unsigned p2 = pack2(x[8 * S + 4], x[8 * S + 5]);
  unsigned p3 = pack2(x[8 * S + 6], x[8 * S + 7]);
  uint4 u = make_uint4(p0, p1, p2, p3);
  return __builtin_bit_cast(bf16x8, u);
}
DI bf16x8 ld_perm(const bf16* p) {
  s16x4 lo = *reinterpret_cast<const s16x4*>(p);
  s16x4 hi = *reinterpret_cast<const s16x4*>(p + 8);
  return __builtin_shufflevector(lo, hi, 0, 1, 2, 3, 4, 5, 6, 7);
}

DI float win_src(const float* __restrict__ w, const float* __restrict__ w2, int k, int n) {
  if (n >= C_LA && n < C_ZA) {
    int dir = (n - C_LA) >> 8, j = (n - C_LA) & 255;
    float s = 0.f;
#pragma unroll
    for (int r = 0; r < 16; ++r) s += w[(long)k * WIN_COLS + 1024 + dir * 16 + r] * w2[(dir * 16 + r) * 256 + j];
    return s;
  }
  int src; float sc = 1.f;
  if (n < 1024) { src = n; if (n < 256) sc = 0.125f; }
  else if (n < C_DQ) src = 1056 + n - C_ZA;
  else if (n < C_DK) { src = 1568 + n - C_DQ; sc = 0.125f * LOG2E; }
  else if (n < C_DV) src = 2080 + n - C_DK;
  else if (n < C_ZB) src = 2592 + n - C_DV;
  else if (n < C_CQ) src = 3104 + n - C_ZB;
  else if (n < C_ZC) { src = 3616 + n - C_CQ; sc = 0.08838834764831845f * LOG2E; }
  else if (n < C_GATE) src = 4128 + n - C_ZC;
  else src = 4640 + n - C_GATE;
  return w[(long)k * WIN_COLS + src] * sc;
}

constexpr int PREP_TILES = 8192 + 1024 + 1536 + 1024;
constexpr int PREP_L0 = 2048 + 256 + 384 + 256;
constexpr int PREP_DEF = PREP_TILES - PREP_L0;
DI int prep_l0_tile(int d) {
  if (d < 2048) return d;
  if (d < 2304) return 8192 + (d - 2048);
  if (d < 2688) return 9216 + (d - 2304);
  return 10752 + (d - 2688);
}
DI int prep_def_tile(int d) {
  if (d < 6144) return 2048 + d;
  if (d < 6912) return 8192 + 256 + (d - 6144);
  if (d < 8064) return 9216 + 384 + (d - 6912);
  return 10752 + 256 + (d - 8064);
}
DI void prep_tile(const Params& p, int tile, char* smem) {
  float* ts = reinterpret_cast<float*>(smem);
  const int tid = otid();
  int kind, l, bi = 0, kt, nt, Kdim;
  if (tile < 8192) { kind = 0; l = tile / 2048; int r = tile % 2048; kt = r / 128; nt = r % 128; Kdim = 1024; }
  else if (tile < 9216) { kind = 1; int t = tile - 8192; l = t / 256; int r = t % 256; kt = r / 16; nt = r % 16; Kdim = 1024; }
  else if (tile < 10752) { kind = 2; int t = tile - 9216; l = t / 384; int r = t % 384; bi = r / 128; int r2 = r % 128; kt = r2 / 16; nt = r2 % 16; Kdim = 512; }
  else { kind = 3; int t = tile - 10752; l = t / 256; int r = t % 256; kt = r / 16; nt = r % 16; Kdim = 1024; }
  const int k0 = kt * 64, n0 = nt * 64;
  const int nn = tid & 63, kq = tid >> 6;
#pragma unroll 4
  for (int i = 0; i < 16; ++i) {
    int kk = kq + 4 * i, k = k0 + kk, n = n0 + nn;
    float v;
    if (kind == 0) v = win_src(p.w_in + (long)l * 1024 * WIN_COLS, p.w2 + l * 2 * 16 * 256, k, n) * p.norm_g[l * 1024 + k];
    else if (kind == 1) v = p.w_mem_kv[((long)l * 1024 + k) * 1024 + n] * p.mem_norm_g[l * 1024 + k];
    else if (kind == 2) v = p.w_branch[((long)(l * 3 + bi) * 512 + k) * 1024 + n];
    else v = p.w_out[((long)l * 1024 + k) * 1024 + n];
    ts[kk * 65 + nn] = v;
  }
  __syncthreads();
  bf16* dst;
  if (kind == 0) dst = p.Win + (long)l * NIN * 1024;
  else if (kind == 1) dst = p.Wkv + (long)l * 1024 * 1024;
  else if (kind == 2) dst = p.Wb + (long)l * 1024 * 1536 + bi * 512;
  else dst = p.Wout + (long)l * 1024 * 1024;
#pragma unroll 4
  for (int i = 0; i < 16; ++i) {
    int nn2 = kq + 4 * i;
    dst[(long)(n0 + nn2) * (kind == 2 ? 1536 : Kdim) + k0 + nn] = f2bf(ts[nn * 65 + nn2]);
  }
  __syncthreads();
}

DI float wave_sum(float v) {
#pragma unroll
  for (int o = 32; o >= 1; o >>= 1) v += __shfl_xor(v, o);
  return v;
}
DI void rownorm_bf16_row(const float* __restrict__ src, bf16* __restrict__ dst, int lane) {
  float4 v[4]; float ss = 0.f;
#pragma unroll
  for (int i = 0; i < 4; ++i) { v[i] = reinterpret_cast<const float4*>(src)[lane + 64 * i]; ss += v[i].x * v[i].x + v[i].y * v[i].y + v[i].z * v[i].z + v[i].w * v[i].w; }
  ss = wave_sum(ss);
  float rs = rsqrtf(ss * (1.f / 1024.f) + EPSN);
#pragma unroll
  for (int i = 0; i < 4; ++i) {
    uint2 o = make_uint2(pack2(v[i].x * rs, v[i].y * rs), pack2(v[i].z * rs, v[i].w * rs));
    reinterpret_cast<uint2*>(dst)[lane + 64 * i] = o;
  }
}
DI void rownorm_final_row(float* __restrict__ row, const float* __restrict__ g, int lane) {
  float4 v[4]; float ss = 0.f;
#pragma unroll
  for (int i = 0; i < 4; ++i) { v[i] = reinterpret_cast<const float4*>(row)[lane + 64 * i]; ss += v[i].x * v[i].x + v[i].y * v[i].y + v[i].z * v[i].z + v[i].w * v[i].w; }
  ss = wave_sum(ss);
  float rs = rsqrtf(ss * (1.f / 1024.f) + EPSN);
#pragma unroll
  for (int i = 0; i < 4; ++i) {
    float4 gg = reinterpret_cast<const float4*>(g)[lane + 64 * i];
    float4 o = make_float4(v[i].x * rs * gg.x, v[i].y * rs * gg.y, v[i].z * rs * gg.z, v[i].w * rs * gg.w);
    reinterpret_cast<float4*>(row)[lane + 64 * i] = o;
  }
}

DI void rownorm_bf16_rows4(const float* __restrict__ src, bf16* __restrict__ dst, long r0, long rstride, int lane) {
  float4 v[4][4]; float ss[4];
#pragma unroll
  for (int k = 0; k < 4; ++k) {
    const float4* s4 = reinterpret_cast<const float4*>(src + (r0 + k * rstride) * 1024);
#pragma unroll
    for (int i = 0; i < 4; ++i) v[k][i] = s4[lane + 64 * i];
  }
#pragma unroll
  for (int k = 0; k < 4; ++k) {
    float a = 0.f;
#pragma unroll
    for (int i = 0; i < 4; ++i) a += v[k][i].x * v[k][i].x + v[k][i].y * v[k][i].y + v[k][i].z * v[k][i].z + v[k][i].w * v[k][i].w;
    ss[k] = a;
  }
#pragma unroll
  for (int o = 32; o >= 1; o >>= 1) {
#pragma unroll
    for (int k = 0; k < 4; ++k) ss[k] += __shfl_xor(ss[k], o);
  }
#pragma unroll
  for (int k = 0; k < 4; ++k) {
    const float rs = rsqrtf(ss[k] * (1.f / 1024.f) + EPSN);
    uint2* d2 = reinterpret_cast<uint2*>(dst + (r0 + k * rstride) * 1024);
#pragma unroll
    for (int i = 0; i < 4; ++i)
      d2[lane + 64 * i] = make_uint2(pack2(v[k][i].x * rs, v[k][i].y * rs), pack2(v[k][i].z * rs, v[k][i].w * rs));
  }
}

constexpr int GSTR = 72;
constexpr int GBUF = 2 * 128 * GSTR;
#define GEMM_LDG(R, kk)                                                     \
  R##a0 = *reinterpret_cast<const uint4*>(Ap + (kk));                      \
  R##a1 = *reinterpret_cast<const uint4*>(Ap + (long)32 * lda + (kk));     \
  R##a2 = *reinterpret_cast<const uint4*>(Ap + (long)64 * lda + (kk));     \
  R##a3 = *reinterpret_cast<const uint4*>(Ap + (long)96 * lda + (kk));     \
  R##b0 = *reinterpret_cast<const uint4*>(Bp + (kk));                      \
  R##b1 = *reinterpret_cast<const uint4*>(Bp + (long)32 * ldb + (kk));     \
  R##b2 = *reinterpret_cast<const uint4*>(Bp + (long)64 * ldb + (kk));     \
  R##b3 = *reinterpret_cast<const uint4*>(Bp + (long)96 * ldb + (kk));
#define GEMM_STS(R, bufo)                                                     \
  *reinterpret_cast<uint4*>(Asw + (bufo)) = R##a0;                            \
  *reinterpret_cast<uint4*>(Asw + (bufo) + 32 * GSTR) = R##a1;                \
  *reinterpret_cast<uint4*>(Asw + (bufo) + 64 * GSTR) = R##a2;                \
  *reinterpret_cast<uint4*>(Asw + (bufo) + 96 * GSTR) = R##a3;                \
  *reinterpret_cast<uint4*>(Asw + (bufo) + 128 * GSTR) = R##b0;               \
  *reinterpret_cast<uint4*>(Asw + (bufo) + 160 * GSTR) = R##b1;               \
  *reinterpret_cast<uint4*>(Asw + (bufo) + 192 * GSTR) = R##b2;               \
  *reinterpret_cast<uint4*>(Asw + (bufo) + 224 * GSTR) = R##b3;
#define GEMM_COMPUTE(bufo)                                                                                                   \
  {                                                                                                                          \
    const bf16* Asr = As + (bufo);                                                                                           \
    const bf16* Bsr = Asr + 128 * GSTR;                                                                                      \
    _Pragma("unroll") for (int ks = 0; ks < 4; ++ks) {                                                                       \
      bf16x8 a[2], b[2];                                                                                                     \
      _Pragma("unroll") for (int i = 0; i < 2; ++i)                                                                          \
          a[i] = *reinterpret_cast<const bf16x8*>(Asr + (wm * 64 + i * 32 + l31) * GSTR + ks * 16 + hh * 8);                 \
      _Pragma("unroll") for (int j = 0; j < 2; ++j)                                                                          \
          b[j] = *reinterpret_cast<const bf16x8*>(Bsr + (wn * 64 + j * 32 + l31) * GSTR + ks * 16 + hh * 8);                 \
      _Pragma("unroll") for (int i = 0; i < 2; ++i)                                                                          \
        _Pragma("unroll") for (int j = 0; j < 2; ++j) acc[i][j] = MFMA(a[i], b[j], acc[i][j]);                               \
    }                                                                                                                        \
  }
DI void gemm_mainloop(const bf16* __restrict__ A, int lda, const bf16* __restrict__ B, int ldb, int K,
                      f32x16 (&acc)[2][2], char* smem) {
  bf16* As = reinterpret_cast<bf16*>(smem);
  const int tid = otid(), lane = tid & 63, wave = tid >> 6, wm = wave >> 1, wn = wave & 1, hh = lane >> 5, l31 = lane & 31;
  uint4 pa0, pa1, pa2, pa3, pb0, pb1, pb2, pb3;
  uint4 qa0, qa1, qa2, qa3, qb0, qb1, qb2, qb3;
  const int lrow = tid >> 3, lc = tid & 7;
  const bf16* Ap = A + (long)lrow * lda + lc * 8;
  const bf16* Bp = B + (long)lrow * ldb + lc * 8;
  bf16* Asw = As + lrow * GSTR + lc * 8;
  GEMM_LDG(p, 0)
  GEMM_LDG(q, 64)
  GEMM_STS(p, 0)
  if (K > 128) { GEMM_LDG(p, 128) }
  __syncthreads();
  for (int k0 = 0; k0 < K; k0 += 128) {
    GEMM_STS(q, GBUF)
    if (k0 + 192 < K) { GEMM_LDG(q, k0 + 192) }
    GEMM_COMPUTE(0)
    __syncthreads();
    if (k0 + 128 < K) { GEMM_STS(p, 0) }
    if (k0 + 256 < K) { GEMM_LDG(p, k0 + 256) }
    GEMM_COMPUTE(GBUF)
    __syncthreads();
  }
}

DI void gemm_mainloop1(const bf16* __restrict__ A, int lda, const bf16* __restrict__ B, int ldb, int K,
                       f32x16 (&acc)[2][2], char* smem) {
  bf16* As = reinterpret_cast<bf16*>(smem);
  const int tid = otid(), lane = tid & 63, wave = tid >> 6, wm = wave >> 1, wn = wave & 1, hh = lane >> 5, l31 = lane & 31;
  uint4 pa0, pa1, pa2, pa3, pb0, pb1, pb2, pb3;
  const int lrow = tid >> 3, lc = tid & 7;
  const bf16* Ap = A + (long)lrow * lda + lc * 8;
  const bf16* Bp = B + (long)lrow * ldb + lc * 8;
  bf16* Asw = As + lrow * GSTR + lc * 8;
  GEMM_LDG(p, 0)
  GEMM_STS(p, 0)
  GEMM_LDG(p, 64)
  __syncthreads();
  for (int k0 = 0; k0 < K; k0 += 128) {
    GEMM_STS(p, GBUF)
    if (k0 + 128 < K) { GEMM_LDG(p, k0 + 128) }
    GEMM_COMPUTE(0)
    __syncthreads();
    if (k0 + 128 < K) { GEMM_STS(p, 0) }
    if (k0 + 192 < K) { GEMM_LDG(p, k0 + 192) }
    GEMM_COMPUTE(GBUF)
    __syncthreads();
  }
}

DI void zero_acc(f32x16 (&acc)[2][2]) {
#pragma unroll
  for (int i = 0; i < 2; ++i)
#pragma unroll
    for (int j = 0; j < 2; ++j)
#pragma unroll
      for (int r = 0; r < 16; ++r) acc[i][j][r] = 0.f;
}

constexpr int CSTR = 132;
template <int MODE>
DI void epi_pack_store(const f32x16 (&acc)[2][2], bf16* __restrict__ dst, long ld, char* smem) {
  bf16* Cs = reinterpret_cast<bf16*>(smem);
  const int tid = otid(), lane = tid & 63, wave = tid >> 6, wm = wave >> 1, wn = wave & 1, hh = lane >> 5, l31 = lane & 31;
#pragma unroll
  for (int i = 0; i < 2; ++i)
#pragma unroll
    for (int j = 0; j < 2; ++j)
#pragma unroll
      for (int rq = 0; rq < 4; ++rq) {
        float v0 = acc[i][j][4 * rq], v1 = acc[i][j][4 * rq + 1], v2 = acc[i][j][4 * rq + 2], v3 = acc[i][j][4 * rq + 3];
        if (MODE == 1) { v0 = siluf(v0); v1 = siluf(v1); v2 = siluf(v2); v3 = siluf(v3); }
        else if (MODE == 2) { v0 = sigmf(v0); v1 = sigmf(v1); v2 = sigmf(v2); v3 = sigmf(v3); }
        const int s = wn * 64 + j * 32 + l31, f = wm * 64 + i * 32 + 8 * rq + 4 * hh;
        *reinterpret_cast<uint2*>(Cs + s * CSTR + f) = make_uint2(pack2(v0, v1), pack2(v2, v3));
      }
  __syncthreads();
#pragma unroll
  for (int it = 0; it < 16; ++it) {
    const int id = tid + it * 256, s = id >> 5, c = id & 31;
    const uint2 v = *reinterpret_cast<const uint2*>(Cs + s * CSTR + c * 4);
    __builtin_nontemporal_store(__builtin_bit_cast(unsigned long long, v), reinterpret_cast<unsigned long long*>(dst + (long)s * ld + c * 4));
  }
  __syncthreads();
}

DI void gin_tile(const Params& p, const Grp& G, int l, int gslot, int tile, char* smem) {
  const int mt = tile >> 6, nt = tile & 63, m0 = mt * 128, n0 = nt * 128;
  const bool is_la = (n0 >= C_LA && n0 < C_ZA);
  const bool tr_gv = (n0 >= C_GV && n0 < C_LA), tr_dv = (n0 >= C_DV && n0 < C_ZB);
  const bool swp = !(is_la || tr_gv || tr_dv);
  const bf16* Xp = p.xn + (long)m0 * 1024;
  const bf16* Wp = p.Win + ((long)l * NIN + n0) * 1024;
  f32x16 acc[2][2];
  zero_acc(acc);
  gemm_mainloop(swp ? Wp : Xp, 1024, swp ? Xp : Wp, 1024, 1024, acc, smem);
  if (is_la) {
    const int tid = otid(), lane = tid & 63, wave = tid >> 6, wm = wave >> 1, wn = wave & 1, hh = lane >> 5, l31 = lane & 31;
    const float* b2 = p.b2 + l * 512;
#pragma unroll
    for (int i = 0; i < 2; ++i)
#pragma unroll
      for (int j = 0; j < 2; ++j) {
        int cn = n0 - C_LA + wn * 64 + j * 32 + l31;
        float bb = b2[cn];
#pragma unroll
        for (int r = 0; r < 16; ++r) {
          int row = m0 + wm * 64 + i * 32 + crow(r, hh);
          p.la[(long)row * 512 + cn] = logsigf(acc[i][j][r] + bb) * 0.0625f;
        }
      }
  } else if (tr_gv || tr_dv) {
    int head = tr_gv ? (n0 - C_GV) >> 7 : (n0 - C_DV) >> 7;
    int seq = m0 / G.T, t0 = m0 % G.T;
    bf16* base = (tr_gv ? p.gvT : p.dvT) + (long)((seq * 4 + head) * 128) * G.T + t0;
    epi_pack_store<0>(acc, base, G.T, smem);
  } else {
    if (n0 >= C_DK && n0 < C_DV) {
      const int tid = otid(), lane = tid & 63, wave = tid >> 6, wm = wave >> 1;
      float v = 0.f;
#pragma unroll
      for (int j = 0; j < 2; ++j) {
        float ss = 0.f;
#pragma unroll
        for (int i = 0; i < 2; ++i)
#pragma unroll
          for (int r = 0; r < 16; ++r) ss += acc[i][j][r] * acc[i][j][r];
        ss += __shfl_xor(ss, 32);
        v = fmaxf(v, ss);
      }
#pragma unroll
      for (int o = 16; o >= 1; o >>= 1) v = fmaxf(v, __shfl_xor(v, o));
      if (lane == 0) atomicMax(p.knmax + (gslot * 8 + m0 / G.T) * 8 + ((n0 - C_DK) >> 7) * 2 + wm, __float_as_int(v));
    }
    bf16* dstp = p.proj + (long)m0 * NIN + n0;
    if ((n0 >= C_ZA && n0 < C_DQ) || (n0 >= C_ZB && n0 < C_CQ) || (n0 >= C_ZC && n0 < C_GATE)) epi_pack_store<1>(acc, dstp, NIN, smem);
    else if (n0 >= C_GATE) epi_pack_store<2>(acc, dstp, NIN, smem);
    else epi_pack_store<0>(acc, dstp, NIN, smem);
  }
}

constexpr int GKV_TILES = NLAYER * 68 * 8;
DI void gkv_tile(const Params& p, int u, char* smem) {
  const int l = u / 544, r = u % 544, mt = r >> 3, nt = r & 7;
  const bool swp = nt < 4;
  const bf16* Xp = p.memn + (long)mt * 128 * 1024;
  const bf16* Wp = p.Wkv + ((long)l * 1024 + nt * 128) * 1024;
  f32x16 acc[2][2];
  zero_acc(acc);
  gemm_mainloop(swp ? Wp : Xp, 1024, swp ? Xp : Wp, 1024, 1024, acc, smem);
  if (swp) {
    epi_pack_store<0>(acc, p.kmem + ((long)l * MEMROWS + mt * 128) * 512 + nt * 128, 512, smem);
  } else {
    int head = nt - 4, b = mt >> 1, mrow0 = (mt & 1) * 128;
    epi_pack_store<0>(acc, p.vmemT + (long)l * (34 * 4 * 128 * 256) + (long)((b * 4 + head) * 128) * 256 + mrow0, 256, smem);
  }
}

template <int HD, int NS, bool ALIBI>
DI void attn_pass(const bf16* __restrict__ Q, int ldq, const bf16* __restrict__ Kg, int ldk,
                  const bf16* __restrict__ VTg, int ldvt, int nkeys, int kstart, float slope2, float qpos, int kcol0,
                  const int* __restrict__ kn2p, f32x16 (&O)[4], float& linv, char* smem) {
  constexpr int KSTR = HD + 8, VSTR = 68, KCH = HD / 8, KPT = 64 * KCH / 256;
  bf16* Ks = reinterpret_cast<bf16*>(smem);
  bf16* VTs = Ks + 64 * KSTR;
  const int tid = otid(), lane = tid & 63, wave = tid >> 6, hh = lane >> 5, l31 = lane & 31;
  bf16x8 qf[NS];
#pragma unroll
  for (int s = 0; s < NS; ++s) qf[s] = *reinterpret_cast<const bf16x8*>(Q + (long)l31 * ldq + s * 16 + hh * 8);
  uint4 kr0, kr1, kr2, kr3, vr0, vr1, vr2, vr3;
  kr2 = make_uint4(0, 0, 0, 0); kr3 = kr2;
  const int krow_ = tid / KCH, kc_ = tid % KCH;
  constexpr int KRS = 256 / KCH;
  const int vrow_ = tid >> 3, vc_ = tid & 7;
  const bf16* Kp = Kg + (long)krow_ * ldk + kc_ * 8;
  const bf16* Vp = VTg + (long)vrow_ * ldvt + vc_ * 8;
#define ATT_LDG(kk)                                                                   \
  kr0 = *reinterpret_cast<const uint4*>(Kp + (long)(kk) * ldk);                        \
  kr1 = *reinterpret_cast<const uint4*>(Kp + (long)((kk) + KRS) * ldk);                \
  if (KPT > 2) {                                                                      \
    kr2 = *reinterpret_cast<const uint4*>(Kp + (long)((kk) + 2 * KRS) * ldk);          \
    kr3 = *reinterpret_cast<const uint4*>(Kp + (long)((kk) + 3 * KRS) * ldk);          \
  }                                                                                   \
  vr0 = *reinterpret_cast<const uint4*>(Vp + (kk));                                    \
  vr1 = *reinterpret_cast<const uint4*>(Vp + (long)32 * ldvt + (kk));                  \
  vr2 = *reinterpret_cast<const uint4*>(Vp + (long)64 * ldvt + (kk));                  \
  vr3 = *reinterpret_cast<const uint4*>(Vp + (long)96 * ldvt + (kk));
  int wlo = 0, whi = nkeys;
  if (ALIBI) {
    float ss = 0.f;
#pragma unroll
    for (int s = 0; s < NS; ++s)
#pragma unroll
      for (int e = 0; e < 8; ++e) { float qv = bf2f((bf16)qf[s][e]); ss += qv * qv; }
    ss += __shfl_xor(ss, 32);
#pragma unroll
    for (int o = 16; o >= 1; o >>= 1) ss = fmaxf(ss, __shfl_xor(ss, o));
    const float kn2 = __int_as_float(__hip_atomic_load(kn2p, __ATOMIC_RELAXED, __HIP_MEMORY_SCOPE_AGENT));
    const float Dw = (2.04f * sqrtf(ss * kn2) + 40.f) / slope2;
    float* xd = reinterpret_cast<float*>(smem + 70656);
    if (lane == 0) xd[wave] = Dw;
    __syncthreads();
    const float D = fmaxf(fmaxf(xd[0], xd[1]), fmaxf(xd[2], xd[3]));
    const float lo = (float)kstart - D, hi = (float)(kstart + 64) + D;
    if (lo > 0.f) wlo = ((int)lo) & ~63;
    if (hi < (float)nkeys) { int h = (((int)hi) + 64) & ~63; whi = h < nkeys ? h : nkeys; }
  }
  const int wspan = whi - wlo;
  const int ntile = wspan >> 6;
#define ATT_WRAP(i) ((kstart + ((i) << 6)) >= whi ? (kstart + ((i) << 6)) - wspan : (kstart + ((i) << 6)))
  { const int kw = ATT_WRAP(0); ATT_LDG(kw) }
  constexpr int ASTG = 64 * KSTR + 128 * VSTR;
  bf16* Ksw = Ks + krow_ * KSTR + kc_ * 8;
  bf16* Vsw = VTs + vrow_ * VSTR + vc_ * 8;
#define ATT_STV(bo, off, v)                                                        \
    reinterpret_cast<uint2*>(Vsw + (bo) + (off) * VSTR)[0] = make_uint2(v.x, v.y); \
    reinterpret_cast<uint2*>(Vsw + (bo) + (off) * VSTR)[1] = make_uint2(v.z, v.w);
#define ATT_STS(bo)                                                           \
    *reinterpret_cast<uint4*>(Ksw + (bo)) = kr0;                              \
    *reinterpret_cast<uint4*>(Ksw + (bo) + KRS * KSTR) = kr1;                 \
    if (KPT > 2) {                                                            \
      *reinterpret_cast<uint4*>(Ksw + (bo) + 2 * KRS * KSTR) = kr2;           \
      *reinterpret_cast<uint4*>(Ksw + (bo) + 3 * KRS * KSTR) = kr3;           \
    }                                                                         \
    ATT_STV(bo, 0, vr0) ATT_STV(bo, 32, vr1) ATT_STV(bo, 64, vr2) ATT_STV(bo, 96, vr3)
  float m_run = -1e30f, l_run = 0.f;
#pragma unroll
  for (int dt = 0; dt < 4; ++dt)
#pragma unroll
    for (int r = 0; r < 16; ++r) O[dt][r] = 0.f;
  ATT_STS(0)
  if (ntile > 1) { const int kw = ATT_WRAP(1); ATT_LDG(kw) }
  __syncthreads();
  const float qk = qpos - (float)(4 * hh);
  for (int it = 0; it < ntile; ++it) {
    const int cur = it & 1;
    if (it + 1 < ntile) { const int bo = (cur ^ 1) * ASTG; ATT_STS(bo) }
    if (it + 2 < ntile) { const int kw = ATT_WRAP(it + 2); ATT_LDG(kw) }
    const int k0 = ATT_WRAP(it);
    const float qk0 = qk - (float)k0;
    const bf16* Ksr = Ks + cur * ASTG;
    const bf16* VTr = VTs + cur * ASTG;
    f32x16 st[2];
#pragma unroll
    for (int mt = 0; mt < 2; ++mt) {
#pragma unroll
      for (int r = 0; r < 16; ++r) st[mt][r] = 0.f;
#pragma unroll
      for (int s = 0; s < NS; ++s) {
        bf16x8 kf = *reinterpret_cast<const bf16x8*>(Ksr + (mt * 32 + l31) * KSTR + kcol0 + s * 16 + hh * 8);
        st[mt] = MFMA(kf, qf[s], st[mt]);
      }
    }
    float mx = -1e30f;
#pragma unroll
    for (int mt = 0; mt < 2; ++mt)
#pragma unroll
      for (int r = 0; r < 16; ++r) {
        float x = st[mt][r];
        if (ALIBI) { x = __builtin_fmaf(-slope2, fabsf(qk0 - (float)(mt * 32 + (r & 3) + 8 * (r >> 2))), x); st[mt][r] = x; }
        mx = fmaxf(mx, x);
      }
    mx = fmaxf(mx, __shfl_xor(mx, 32));
    if (!ALIBI || __builtin_amdgcn_ballot_w64(mx - m_run > -40.f) != 0) {
    const float m_new = fmaxf(m_run, mx);
    const float alpha = fexp2(m_run - m_new);
    m_run = m_new;
    float ls = 0.f;
#pragma unroll
    for (int mt = 0; mt < 2; ++mt)
#pragma unroll
      for (int r = 0; r < 16; ++r) { float pv = fexp2(st[mt][r] - m_new); ls += pv; st[mt][r] = pv; }
    l_run = l_run * alpha + ls;
    if (!ALIBI || __builtin_amdgcn_ballot_w64(alpha != 1.f) != 0) {
#pragma unroll
      for (int dt = 0; dt < 4; ++dt)
#pragma unroll
        for (int r = 0; r < 16; ++r) O[dt][r] *= alpha;
    }
#pragma unroll
    for (int mt = 0; mt < 2; ++mt) {
      bf16x8 pf0 = pack8<0>(st[mt]), pf1 = pack8<1>(st[mt]);
#pragma unroll
      for (int dt = 0; dt < 4; ++dt) {
        bf16x8 v0 = ld_perm(VTr + (dt * 32 + l31) * VSTR + mt * 32 + 0 + 4 * hh);
        O[dt] = MFMA(v0, pf0, O[dt]);
        bf16x8 v1 = ld_perm(VTr + (dt * 32 + l31) * VSTR + mt * 32 + 16 + 4 * hh);
        O[dt] = MFMA(v1, pf1, O[dt]);
      }
    }
    }
    __syncthreads();
  }
  float l = l_run + __shfl_xor(l_run, 32);
  linv = 1.f / l;
}

DI void diff_item(const Params& p, const Grp& G, int l, int gslot, int idx, char* smem) {
  const int nqb = G.T >> 6;
  const int qb = idx % nqb, head = (idx / nqb) & 3, seq = idx / (nqb * 4);
  const int tid = otid(), lane = tid & 63, wave = tid >> 6, hh = lane >> 5, l31 = lane & 31;
  const int ps = wave >> 1, rw = wave & 1;
  const float* lp = p.diff_lambda + l * 256;
  float s1 = wave_sum(lp[lane] * lp[64 + lane]);
  float s2 = wave_sum(lp[128 + lane] * lp[192 + lane]);
  const float lam = __expf(s1) - __expf(s2) + p.lam_init[l];
  const float slope2 = exp2f(-2.f * (float)(head + 1)) * LOG2E;
  const long mrow0 = (long)seq * G.T + qb * 64 + rw * 32;
  const bf16* VT = p.dvT + (long)((seq * 4 + head) * 128) * G.T;
  f32x16 O[4];
  float linv;
  attn_pass<128, 4, true>(p.proj + mrow0 * NIN + C_DQ + head * 128 + ps * 64, NIN,
                          p.proj + (long)seq * G.T * NIN + C_DK + head * 128, NIN,
                          VT, G.T, G.T, qb * 64, slope2, (float)(qb * 64 + rw * 32 + l31), ps * 64,
                          p.knmax + (gslot * 8 + seq) * 8 + head * 2 + ps, O, linv, smem);
  float* xs = reinterpret_cast<float*>(smem) + (rw * 64) * 64 + lane;
  if (ps == 1) {
#pragma unroll
    for (int dt = 0; dt < 4; ++dt)
#pragma unroll
      for (int r = 0; r < 16; ++r) xs[(dt * 16 + r) * 64] = O[dt][r] * linv;
  }
  __syncthreads();
  if (ps == 0) {
    float ss = 0.f;
#pragma unroll
    for (int dt = 0; dt < 4; ++dt)
#pragma unroll
      for (int r = 0; r < 16; ++r) { float o = O[dt][r] * linv - lam * xs[(dt * 16 + r) * 64]; O[dt][r] = o; ss += o * o; }
    ss += __shfl_xor(ss, 32);
    const float rs = rsqrtf(ss * (1.f / 128.f) + EPSN) * (1.f - p.lam_init[l]);
    const long m = mrow0 + l31;
    const float* gn = p.diff_norm_g + l * 128;
#pragma unroll
    for (int dt = 0; dt < 4; ++dt)
#pragma unroll
      for (int rq = 0; rq < 4; ++rq) {
        int dv0 = dt * 32 + 8 * rq + 4 * hh;
        uint2 zz = *reinterpret_cast<const uint2*>(p.proj + m * NIN + C_ZB + head * 128 + dv0);
        float4 g4 = *reinterpret_cast<const float4*>(gn + dv0);
        float y0 = O[dt][4 * rq + 0] * rs * g4.x * bf2f((bf16)(zz.x & 0xffff));
        float y1 = O[dt][4 * rq + 1] * rs * g4.y * bf2f((bf16)(zz.x >> 16));
        float y2 = O[dt][4 * rq + 2] * rs * g4.z * bf2f((bf16)(zz.y & 0xffff));
        float y3 = O[dt][4 * rq + 3] * rs * g4.w * bf2f((bf16)(zz.y >> 16));
        *reinterpret_cast<uint2*>(p.br + m * 1536 + 512 + head * 128 + dv0) = make_uint2(pack2(y0, y1), pack2(y2, y3));
      }
  }
  __syncthreads();
}

DI void cross_item(const Params& p, const Grp& G, int l, int idx, char* smem) {
  const int nqb = G.T >> 7;
  const int qb = idx % nqb, head = (idx / nqb) & 3, seq = idx / (nqb * 4);
  const int tid = otid(), lane = tid & 63, wave = tid >> 6, hh = lane >> 5, l31 = lane & 31;
  const long mrow0 = (long)seq * G.T + qb * 128;
  const int mb = G.mem0 + seq;
  f32x16 O[4];
  float linv;
  attn_pass<128, 8, false>(p.proj + (mrow0 + wave * 32) * NIN + C_CQ + head * 128, NIN,
                        p.kmem + ((long)l * MEMROWS + mb * 256) * 512 + head * 128, 512,
                        p.vmemT + (long)l * (34 * 4 * 128 * 256) + (long)((mb * 4 + head) * 128) * 256, 256,
                        256, 0, 0.f, 0.f, 0, nullptr, O, linv, smem);
  const long m = mrow0 + wave * 32 + l31;
#pragma unroll
  for (int dt = 0; dt < 4; ++dt)
#pragma unroll
    for (int rq = 0; rq < 4; ++rq) {
      int dv0 = dt * 32 + 8 * rq + 4 * hh;
      uint2 zz = *reinterpret_cast<const uint2*>(p.proj + m * NIN + C_ZC + head * 128 + dv0);
      float y0 = O[dt][4 * rq + 0] * linv * bf2f((bf16)(zz.x & 0xffff));
      float y1 = O[dt][4 * rq + 1] * linv * bf2f((bf16)(zz.x >> 16));
      float y2 = O[dt][4 * rq + 2] * linv * bf2f((bf16)(zz.y & 0xffff));
      float y3 = O[dt][4 * rq + 3] * linv * bf2f((bf16)(zz.y >> 16));
      *reinterpret_cast<uint2*>(p.br + m * 1536 + 1024 + head * 128 + dv0) = make_uint2(pack2(y0, y1), pack2(y2, y3));
    }
}

DI void gla_item(const Params& p, const Grp& G, int l, int idx, char* smem) {
  const int seq = idx >> 3, head = (idx >> 1) & 3, dir = idx & 1;
  const int T = G.T, nch = T >> 6;
  bf16* qt = reinterpret_cast<bf16*>(smem);
  bf16* kt = qt + 64 * 72;
  bf16* ktT = kt + 64 * 72;
  bf16* vT = ktT + 64 * 72;
  float* tot = reinterpret_cast<float*>(vT + 128 * 72);
  float* eb = tot + 256;
  const int tid = otid(), lane = tid & 63, wave = tid >> 6, hh = lane >> 5, l31 = lane & 31;
  const int d = tid & 63, g = tid >> 6;
  f32x16 S[2];
#pragma unroll
  for (int dt = 0; dt < 2; ++dt)
#pragma unroll
    for (int r = 0; r < 16; ++r) S[dt][r] = 0.f;
  const bf16* projg = p.proj + (long)seq * T * NIN;
  const float* lag = p.la + (long)seq * T * 512 + dir * 256 + head * 64;
  const bf16* vTg = p.gvT + (long)((seq * 4 + head) * 128) * T;
  float* og = p.glao + (long)dir * MG * 512 + (long)seq * T * 512 + head * 128;
  for (int ci = 0; ci < nch; ++ci) {
    const int c = dir ? nch - 1 - ci : ci, t0 = c * 64;
    float cs[16], qr[16], kr[16];
    uint4 vv0, vv1, vv2, vv3;
#pragma unroll
    for (int i = 0; i < 16; ++i) {
      long t = t0 + 16 * g + i;
      cs[i] = lag[t * 512 + d];
      qr[i] = bf2f(projg[t * NIN + C_GQ + head * 64 + d]);
      kr[i] = bf2f(projg[t * NIN + C_GK + head * 64 + d]);
    }
    {
      const bf16* vp = vTg + (long)(tid >> 3) * T + t0 + (tid & 7) * 8;
      vv0 = *reinterpret_cast<const uint4*>(vp);
      vv1 = *reinterpret_cast<const uint4*>(vp + (long)32 * T);
      vv2 = *reinterpret_cast<const uint4*>(vp + (long)64 * T);
      vv3 = *reinterpret_cast<const uint4*>(vp + (long)96 * T);
    }
    float run = 0.f;
    if (dir == 0) {
#pragma unroll
      for (int i = 0; i < 16; ++i) { run += cs[i]; cs[i] = run; }
    } else {
#pragma unroll
      for (int i = 15; i >= 0; --i) { run += cs[i]; cs[i] = run; }
    }
    tot[g * 64 + d] = run;
    __syncthreads();
    float pre = 0.f, total = 0.f;
#pragma unroll
    for (int gg = 0; gg < 4; ++gg) {
      float tv = tot[gg * 64 + d];
      total += tv;
      bool inc = dir == 0 ? (gg < g) : (gg > g);
      if (inc) pre += tv;
    }
    unsigned kp[8];
#pragma unroll
    for (int i = 0; i < 16; i += 2) {
      float b0 = pre + cs[i], b1 = pre + cs[i + 1];
      float q0 = qr[i] * __expf(b0), q1 = qr[i + 1] * __expf(b1);
      float k0v = kr[i] * __expf(-b0), k1v = kr[i + 1] * __expf(-b1);
      unsigned qp = pack2(q0, q1), kpk = pack2(k0v, k1v);
      qt[(16 * g + i) * 72 + d] = (bf16)(qp & 0xffff);
      qt[(16 * g + i + 1) * 72 + d] = (bf16)(qp >> 16);
      kt[(16 * g + i) * 72 + d] = (bf16)(kpk & 0xffff);
      kt[(16 * g + i + 1) * 72 + d] = (bf16)(kpk >> 16);
      kp[i >> 1] = kpk;
    }
    *reinterpret_cast<uint4*>(ktT + d * 72 + 16 * g) = make_uint4(kp[0], kp[1], kp[2], kp[3]);
    *reinterpret_cast<uint4*>(ktT + d * 72 + 16 * g + 8) = make_uint4(kp[4], kp[5], kp[6], kp[7]);
    if (g == 0) eb[d] = __expf(total);
    {
      bf16* vw = vT + (tid >> 3) * 72 + (tid & 7) * 8;
      *reinterpret_cast<uint4*>(vw) = vv0;
      *reinterpret_cast<uint4*>(vw + 32 * 72) = vv1;
      *reinterpret_cast<uint4*>(vw + 64 * 72) = vv2;
      *reinterpret_cast<uint4*>(vw + 96 * 72) = vv3;
    }
    __syncthreads();
    f32x16 AT[2][2];
#pragma unroll
    for (int st = 0; st < 2; ++st)
#pragma unroll
      for (int tt = 0; tt < 2; ++tt) {
#pragma unroll
        for (int r = 0; r < 16; ++r) AT[st][tt][r] = 0.f;
#pragma unroll
        for (int ks = 0; ks < 4; ++ks) {
          bf16x8 a = *reinterpret_cast<const bf16x8*>(kt + (st * 32 + l31) * 72 + ks * 16 + hh * 8);
          bf16x8 b = *reinterpret_cast<const bf16x8*>(qt + (tt * 32 + l31) * 72 + ks * 16 + hh * 8);
          AT[st][tt] = MFMA(a, b, AT[st][tt]);
        }
#pragma unroll
        for (int r = 0; r < 16; ++r) {
          int s = st * 32 + crow(r, hh), t = tt * 32 + l31;
          bool keep = dir == 0 ? (s <= t) : (s >= t);
          if (!keep) AT[st][tt][r] = 0.f;
        }
      }
    f32x16 o[2];
#pragma unroll
    for (int tt = 0; tt < 2; ++tt) {
#pragma unroll
      for (int r = 0; r < 16; ++r) o[tt][r] = 0.f;
#pragma unroll
      for (int st = 0; st < 2; ++st) {
        bf16x8 pa0 = pack8<0>(AT[st][tt]), pa1 = pack8<1>(AT[st][tt]);
        bf16x8 vb0 = ld_perm(vT + (wave * 32 + l31) * 72 + st * 32 + 0 + 4 * hh);
        bf16x8 vb1 = ld_perm(vT + (wave * 32 + l31) * 72 + st * 32 + 16 + 4 * hh);
        o[tt] = MFMA(pa0, vb0, o[tt]);
        o[tt] = MFMA(pa1, vb1, o[tt]);
      }
#pragma unroll
      for (int dt = 0; dt < 2; ++dt) {
        bf16x8 sb0 = pack8<0>(S[dt]), sb1 = pack8<1>(S[dt]);
        bf16x8 qa0 = ld_perm(qt + (tt * 32 + l31) * 72 + dt * 32 + 0 + 4 * hh);
        bf16x8 qa1 = ld_perm(qt + (tt * 32 + l31) * 72 + dt * 32 + 16 + 4 * hh);
        o[tt] = MFMA(qa0, sb0, o[tt]);
        o[tt] = MFMA(qa1, sb1, o[tt]);
      }
#pragma unroll
      for (int r = 0; r < 16; ++r) {
        long t = t0 + tt * 32 + crow(r, hh);
        og[t * 512 + wave * 32 + l31] = o[tt][r];
      }
    }
#pragma unroll
    for (int dt = 0; dt < 2; ++dt) {
#pragma unroll
      for (int ks = 0; ks < 4; ++ks) {
        bf16x8 a = *reinterpret_cast<const bf16x8*>(ktT + (dt * 32 + l31) * 72 + ks * 16 + hh * 8);
        bf16x8 b = *reinterpret_cast<const bf16x8*>(vT + (wave * 32 + l31) * 72 + ks * 16 + hh * 8);
        S[dt] = MFMA(a, b, S[dt]);
      }
#pragma unroll
      for (int r = 0; r < 16; ++r) S[dt][r] *= eb[dt * 32 + crow(r, hh)];
    }
    __syncthreads();
  }
}

DI void gla_combine_row(const Params& p, int l, long m, int lane) {
  const float* a = p.glao + m * 512 + lane * 8;
  const float* b = a + (long)MG * 512;
  float4 a0 = reinterpret_cast<const float4*>(a)[0], a1 = reinterpret_cast<const float4*>(a)[1];
  float4 b0 = reinterpret_cast<const float4*>(b)[0], b1 = reinterpret_cast<const float4*>(b)[1];
  float o[8] = {a0.x + b0.x, a0.y + b0.y, a0.z + b0.z, a0.w + b0.w, a1.x + b1.x, a1.y + b1.y, a1.z + b1.z, a1.w + b1.w};
  float ss = 0.f;
#pragma unroll
  for (int i = 0; i < 8; ++i) ss += o[i] * o[i];
#pragma unroll
  for (int off = 8; off >= 1; off >>= 1) ss += __shfl_xor(ss, off);
  float rs = rsqrtf(ss * (1.f / 128.f) + EPSN);
  const float* gn = p.gla_norm_g + l * 128 + (lane & 15) * 8;
  uint4 zz = *reinterpret_cast<const uint4*>(p.proj + m * NIN + C_ZA + lane * 8);
  unsigned zw[4] = {zz.x, zz.y, zz.z, zz.w};
  unsigned ow[4];
#pragma unroll
  for (int e = 0; e < 4; ++e) {
    float y0 = o[2 * e] * rs * gn[2 * e] * bf2f((bf16)(zw[e] & 0xffff));
    float y1 = o[2 * e + 1] * rs * gn[2 * e + 1] * bf2f((bf16)(zw[e] >> 16));
    ow[e] = pack2(y0, y1);
  }
  *reinterpret_cast<uint4*>(p.br + m * 1536 + lane * 8) = make_uint4(ow[0], ow[1], ow[2], ow[3]);
}

DI void gbr_tile(const Params& p, int l, int tile, char* smem) {
  const int mt = tile >> 3, nt = tile & 7, m0 = mt * 128, n0 = nt * 128;
  f32x16 sum[2][2], acc[2][2];
  zero_acc(sum);
  zero_acc(acc);
  const bf16* A = p.Wb + ((long)l * 1024 + n0) * 1536;
  const bf16* B = p.br + (long)m0 * 1536;
  const int lda = 1536, ldb = 1536, K = 1536;
  bf16* As = reinterpret_cast<bf16*>(smem);
  const int tid = otid(), lane = tid & 63, wave = tid >> 6, wm = wave >> 1, wn = wave & 1, hh = lane >> 5, l31 = lane & 31;
  uint4 pa0, pa1, pa2, pa3, pb0, pb1, pb2, pb3;
  const int lrow = tid >> 3, lc = tid & 7;
  const bf16* Ap = A + (long)lrow * lda + lc * 8;
  const bf16* Bp = B + (long)lrow * ldb + lc * 8;
  bf16* Asw = As + lrow * GSTR + lc * 8;
  GEMM_LDG(p, 0)
  GEMM_STS(p, 0)
  GEMM_LDG(p, 64)
  __syncthreads();
  uint2 g00, g01, g02, g03, g10, g11, g12, g13, g20, g21, g22, g23, g30, g31, g32, g33;
#define GBR_GLD(i, j, rq, dstv) dstv = *reinterpret_cast<const uint2*>(p.proj + (long)(m0 + wn * 64 + (j) * 32 + l31) * NIN + C_GATE + bi_ * 1024 + n0 + wm * 64 + (i) * 32 + 8 * (rq) + 4 * hh);
  for (int k0 = 0; k0 < K; k0 += 128) {
    if ((k0 & 511) == 0) {
      const int bi_ = k0 >> 9;
      GBR_GLD(0, 0, 0, g00) GBR_GLD(0, 0, 1, g01) GBR_GLD(0, 0, 2, g02) GBR_GLD(0, 0, 3, g03)
      GBR_GLD(0, 1, 0, g10) GBR_GLD(0, 1, 1, g11) GBR_GLD(0, 1, 2, g12) GBR_GLD(0, 1, 3, g13)
      GBR_GLD(1, 0, 0, g20) GBR_GLD(1, 0, 1, g21) GBR_GLD(1, 0, 2, g22) GBR_GLD(1, 0, 3, g23)
      GBR_GLD(1, 1, 0, g30) GBR_GLD(1, 1, 1, g31) GBR_GLD(1, 1, 2, g32) GBR_GLD(1, 1, 3, g33)
    }
    GEMM_STS(p, GBUF)
    if (k0 + 128 < K) { GEMM_LDG(p, k0 + 128) }
    GEMM_COMPUTE(0)
    __syncthreads();
    if (k0 + 128 < K) { GEMM_STS(p, 0) }
    if (k0 + 192 < K) { GEMM_LDG(p, k0 + 192) }
    GEMM_COMPUTE(GBUF)
    __syncthreads();
    if (((k0 + 128) & 511) == 0) {
#pragma unroll
      for (int i = 0; i < 2; ++i)
#pragma unroll
        for (int j = 0; j < 2; ++j)
#pragma unroll
          for (int rq = 0; rq < 4; ++rq) {
            const int q = i * 2 + j;
            const uint2 gg = q == 0 ? (rq == 0 ? g00 : rq == 1 ? g01 : rq == 2 ? g02 : g03)
                           : q == 1 ? (rq == 0 ? g10 : rq == 1 ? g11 : rq == 2 ? g12 : g13)
                           : q == 2 ? (rq == 0 ? g20 : rq == 1 ? g21 : rq == 2 ? g22 : g23)
                                    : (rq == 0 ? g30 : rq == 1 ? g31 : rq == 2 ? g32 : g33);
            sum[i][j][4 * rq + 0] += bf2f((bf16)(gg.x & 0xffff)) * acc[i][j][4 * rq + 0];
            sum[i][j][4 * rq + 1] += bf2f((bf16)(gg.x >> 16)) * acc[i][j][4 * rq + 1];
            sum[i][j][4 * rq + 2] += bf2f((bf16)(gg.y & 0xffff)) * acc[i][j][4 * rq + 2];
            sum[i][j][4 * rq + 3] += bf2f((bf16)(gg.y >> 16)) * acc[i][j][4 * rq + 3];
            acc[i][j][4 * rq + 0] = 0.f; acc[i][j][4 * rq + 1] = 0.f; acc[i][j][4 * rq + 2] = 0.f; acc[i][j][4 * rq + 3] = 0.f;
          }
    }
  }
  epi_pack_store<0>(sum, p.merged + (long)m0 * 1024 + n0, 1024, smem);
}

DI void gout_tile(const Params& p, int l, int tile, const float* __restrict__ xsrc, float* __restrict__ xdst, char* smem) {
  const int mt = tile >> 3, nt = tile & 7, m0 = mt * 128, n0 = nt * 128;
  const int tid = otid(), lane = tid & 63, wave = tid >> 6, wm = wave >> 1, wn = wave & 1, hh = lane >> 5, l31 = lane & 31;
  f32x16 acc[2][2], xa[2], xb[2];
  zero_acc(acc);
  const float* xs0 = xsrc + (long)(m0 + wm * 64 + 4 * hh) * 1024 + n0 + wn * 64 + l31;
  float* xd0 = xdst + (long)(m0 + wm * 64 + 4 * hh) * 1024 + n0 + wn * 64 + l31;
#pragma unroll
  for (int j = 0; j < 2; ++j)
#pragma unroll
    for (int r = 0; r < 16; ++r) xa[j][r] = xs0[(long)((r & 3) + 8 * (r >> 2)) * 1024 + j * 32];
  gemm_mainloop1(p.merged + (long)m0 * 1024, 1024, p.Wout + ((long)l * 1024 + n0) * 1024, 1024, 1024, acc, smem);
#pragma unroll
  for (int j = 0; j < 2; ++j)
#pragma unroll
    for (int r = 0; r < 16; ++r) xb[j][r] = xs0[(long)(32 + (r & 3) + 8 * (r >> 2)) * 1024 + j * 32];
#pragma unroll
  for (int j = 0; j < 2; ++j)
#pragma unroll
    for (int r = 0; r < 16; ++r) xd0[(long)((r & 3) + 8 * (r >> 2)) * 1024 + j * 32] = xa[j][r] + acc[0][j][r];
#pragma unroll
  for (int j = 0; j < 2; ++j)
#pragma unroll
    for (int r = 0; r < 16; ++r) xd0[(long)(32 + (r & 3) + 8 * (r >> 2)) * 1024 + j * 32] = xb[j][r] + acc[1][j][r];
}

#define XB_TMO      128
#define XB_XCNT(j)  (256  + 64 * (j))
#define XB_XSUB(j)  (1280 + 64 * (j))
#define XB_XGEN(j)  (2304 + 64 * (j))
#define XB_TOP      3328
#define XB_TOPGEN   3392
#define XT_SUB(j)   (3584 + 64 * (j))
#define XT_GEN(j)   (4608 + 64 * (j))
#define XCD_BAR_WORDS 5632
#define XB_SPIN_CAP (1u << 22)
#define LAS __attribute__((address_space(3)))
DI unsigned xb_ld(unsigned* p)              { return __hip_atomic_load(p, __ATOMIC_RELAXED, __HIP_MEMORY_SCOPE_AGENT); }
DI unsigned xb_add(unsigned* p, unsigned v) { return __hip_atomic_fetch_add(p, v, __ATOMIC_RELAXED, __HIP_MEMORY_SCOPE_AGENT); }
DI unsigned xb_xcc_id() { return (unsigned)__builtin_amdgcn_s_getreg((3 << 11) | 20) & 0xFu; }
#define XB_SPIN(cond, bar) do { unsigned _sp = 0; while (cond) { __builtin_amdgcn_s_sleep(1); \
    if ((++_sp & 255u) == 0u) { if (xb_ld(&(bar)[XB_TMO])) break; if (_sp > XB_SPIN_CAP) { atomicAdd(&(bar)[XB_TMO], 1u); break; } } } } while (0)
struct XcdBarrier { unsigned* bar; unsigned x; volatile LAS unsigned* st; };
DI XcdBarrier xcd_barrier_post(unsigned* bar, volatile LAS unsigned* st) {
  XcdBarrier b; b.bar = bar; b.x = xb_xcc_id(); b.st = st;
  if (threadIdx.x == 0) (void)xb_add(&bar[XB_XCNT(b.x)], 1u);
  return b;
}
DI void xcd_barrier_complete(unsigned* bar, unsigned x, unsigned& nloc, unsigned& nx) {
  const unsigned G = gridDim.x * gridDim.y * gridDim.z;
  unsigned sum, cnt, mine, sp = 0u;
  for (;;) {
    sum = 0u; cnt = 0u; mine = 0u;
#pragma unroll
    for (unsigned j = 0; j < 16; ++j) { const unsigned c = xb_ld(&bar[XB_XCNT(j)]); sum += c; cnt += (c > 0u) ? 1u : 0u; mine = (j == x) ? c : mine; }
    if (sum == G) break;
    __builtin_amdgcn_s_sleep(1);
    if ((++sp & 255u) == 0u) { if (xb_ld(&bar[XB_TMO])) break; if (sp > XB_SPIN_CAP) { atomicAdd(&bar[XB_TMO], 1u); break; } }
  }
  nloc = mine > 0u ? mine : 1u; nx = cnt > 0u ? cnt : 1u;
}
DI void xcd_barrier(const XcdBarrier& b) {
  asm volatile("s_waitcnt vmcnt(0)" ::: "memory");
  __syncthreads();
  if (threadIdx.x == 0) {
    unsigned* bar = b.bar;
    __builtin_amdgcn_s_waitcnt(0);
    unsigned nloc = b.st[0], nx = b.st[1];
    if (nloc == 0u) { xcd_barrier_complete(bar, b.x, nloc, nx); b.st[0] = nloc; b.st[1] = nx; }
    const unsigned old = xb_add(&bar[XB_XSUB(b.x)], 1u);
    const unsigned gen = old / nloc;
    if (old + 1u == (gen + 1u) * nloc) {
      __builtin_amdgcn_fence(__ATOMIC_RELEASE, "agent");
      asm volatile("s_waitcnt vmcnt(0)" ::: "memory");
      const unsigned og = xb_add(&bar[XB_TOP], 1u);
      const unsigned tg = og / nx;
      if (og + 1u == (tg + 1u) * nx) xb_add(&bar[XB_TOPGEN], 1u);
      else XB_SPIN(xb_ld(&bar[XB_TOPGEN]) == tg, bar);
      __builtin_amdgcn_fence(__ATOMIC_ACQUIRE, "agent");
      xb_add(&bar[XB_XGEN(b.x)], 1u);
      asm volatile("s_waitcnt vmcnt(0)" ::: "memory");
    } else {
      XB_SPIN(xb_ld(&bar[XB_XGEN(b.x)]) == gen, bar);
      __builtin_amdgcn_fence(__ATOMIC_ACQUIRE, "agent");
      asm volatile("s_waitcnt vmcnt(0)" ::: "memory");
    }
  }
  __syncthreads();
}

DI void team_barrier(const XcdBarrier& b) {
  asm volatile("s_waitcnt vmcnt(0)" ::: "memory");
  __syncthreads();
  if (threadIdx.x == 0) {
    unsigned* bar = b.bar;
    __builtin_amdgcn_s_waitcnt(0);
    const unsigned nloc = b.st[0];
    const unsigned old = xb_add(&bar[XT_SUB(b.x)], 1u);
    const unsigned gen = old / nloc;
    if (old + 1u == (gen + 1u) * nloc) {
      __builtin_amdgcn_fence(__ATOMIC_RELEASE, "agent");
      asm volatile("s_waitcnt vmcnt(0)" ::: "memory");
      __builtin_amdgcn_fence(__ATOMIC_ACQUIRE, "agent");
      xb_add(&bar[XT_GEN(b.x)], 1u);
      asm volatile("s_waitcnt vmcnt(0)" ::: "memory");
    } else {
      XB_SPIN(xb_ld(&bar[XT_GEN(b.x)]) == gen, bar);
      __builtin_amdgcn_fence(__ATOMIC_ACQUIRE, "agent");
      asm volatile("s_waitcnt vmcnt(0)" ::: "memory");
    }
  }
  __syncthreads();
}

__global__ void __launch_bounds__(256, 2) mega(Params p) {
  extern __shared__ __attribute__((aligned(16))) char smem[];
  __shared__ int s_item;
  __shared__ uint4 xb_words;
  cg::grid_group grid = cg::this_grid();
  if (threadIdx.x == 0) xb_words = make_uint4(0u, 0u, 0u, 0u);
  __syncthreads();
  const int nblk = gridDim.x, bid = blockIdx.x;
  const int nwave = nblk * 4;
#define ROW_IDS const int tid = otid(), lane = tid & 63, gwave = bid * 4 + (tid >> 6);

  for (int t = bid; t < PREP_L0; t += nblk) prep_tile(p, prep_l0_tile(t), smem);
  {
    ROW_IDS
    if (bid == 0) { for (int i = tid; i < 1024; i += 256) p.counters[i] = 0; for (int i = tid; i < 2048; i += 256) p.knmax[i] = 0; for (int i = tid; i < XCD_BAR_WORDS; i += 256) p.bar[i] = 0u; }
    for (int r = gwave; r < MEMROWS; r += nwave) {
      const float* src = r < 8192 ? p.mem_prompt + (long)r * 1024 : p.mem_sample + (long)(r - 8192) * 1024;
      rownorm_bf16_row(src, p.memn + (long)r * 1024, lane);
    }
    for (int r = gwave; r < MG; r += nwave) rownorm_bf16_row(p.x_prompt + (long)r * 1024, p.xn + (long)r * 1024, lane);
  }
  grid.sync();
  XcdBarrier xb = xcd_barrier_post(p.bar, (volatile LAS unsigned*)&xb_words);
  __shared__ int s_xm[4];
  {
    const int x = (int)xb_xcc_id();
    if (threadIdx.x == 0) s_xm[1] = atomicAdd(&p.counters[960 + x], 1);
    xcd_barrier(xb);
    if (threadIdx.x == 0) {
      int nx = 0, ok = 1, mine = 0;
      for (int j = 0; j < 16; ++j) {
        int c = __hip_atomic_load(&p.counters[960 + j], __ATOMIC_RELAXED, __HIP_MEMORY_SCOPE_AGENT);
        if (c > 0) ++nx;
        if (j < 8 && c * 8 != nblk) ok = 0;
        if (j >= 8 && c != 0) ok = 0;
        if (j == x) mine = c;
      }
      s_xm[0] = x; s_xm[2] = mine; s_xm[3] = (ok && nx == 8) ? 1 : 0;
    }
    __syncthreads();
  }
  const int xcd = s_xm[0], xrank = s_xm[1], xnl = s_xm[2];
  const bool xaware = s_xm[3] != 0;

  for (int g = 0; g < NGROUP; ++g) {
    const Grp G = get_grp(g);
    const float* xin = g < 4 ? p.x_prompt + (long)g * MG * 1024 : p.x_sample;
    float* xout = p.out + (long)G.tok0 * 1024;
    for (int l = 0; l < NLAYER; ++l) {
      {
        const int kv_lo = (g == 0 && l == 0) ? 0 : 68, kv_hi = (g == 0 && l == 0) ? 68 : ((g == 0 && l == 1) ? 272 : 68);
        const int extra = (kv_hi - kv_lo) * 8;
        const int ntile = 128 * 64 + extra;
        if (xaware) {
          for (int i = xrank; i < 192; i += xnl) gin_tile(p, G, l, g * NLAYER + l, (xcd + 8 * (i / 12)) * 64 + (i % 12), smem);
          for (int i = kv_lo + xrank; i < kv_hi; i += xnl) gkv_tile(p, i * 8 + xcd, smem);
          xcd_barrier(xb);
          {
            const int n_gla = G.nseq == 8 ? 8 : 2, total = n_gla + 832;
            int* ctr = p.counters + 512 + ((g * NLAYER + l) * 8 + xcd);
            while (true) {
              if (otid() == 0) s_item = atomicAdd(ctr, 1);
              __syncthreads();
              const int item = s_item;
              __syncthreads();
              if (item >= total) break;
              if (item < n_gla) {
                const int ph = G.nseq == 8 ? xcd * 4 + (item >> 1) : xcd;
                gla_item(p, G, l, ph * 2 + (item & 1), smem);
              } else {
                const int j = item - n_gla;
                int r, jj, cnt, t1;
                if (j < 384) { r = j / 96; jj = j % 96; cnt = 6; t1 = 2; }
                else { r = 4 + (j - 384) / 112; jj = (j - 384) % 112; cnt = 7; t1 = 1; }
                const int half = jj / (cnt * 8), rem = jj % (cnt * 8);
                const int nt = r + 8 * (t1 + (rem >> 3));
                const int mt = ((((xcd - nt) & 7) + 8 * half) << 3) + (rem & 7);
                gin_tile(p, G, l, g * NLAYER + l, mt * 64 + nt, smem);
              }
            }
          }
        } else {
          for (int t = bid; t < ntile; t += nblk) {
            if (t < 128 * 64) gin_tile(p, G, l, g * NLAYER + l, t, smem);
            else gkv_tile(p, kv_lo * 8 + (t - 128 * 64), smem);
          }
        }
      }
      xcd_barrier(xb);
      {
        const int nqb = G.T >> 7;
        if (xaware) {
          const int nqd = nqb * 2;
          const bool prm = G.nseq == 8;
          const int n_gla = 0, n_dif = prm ? 4 * nqd : nqd, n_att = prm ? 4 * nqb : nqb;
          const int n_cmb = 64;
          const int n_prep = (g == 0 && l == 0) ? PREP_DEF / 8 : 0;
          const int total = n_gla + n_dif + n_att + n_cmb + n_prep;
          const int xs_ = xcd >> 2, xh_ = xcd & 3;
          int* ctr = p.counters + ((g * NLAYER + l) * 8 + xcd);
          while (true) {
            if (otid() == 0) s_item = atomicAdd(ctr, 1);
            __syncthreads();
            const int item = s_item;
            __syncthreads();
            if (item >= total) break;
            if (item < n_gla) {
              const int ph = prm ? xcd * 4 + (item >> 1) : xcd;
              gla_item(p, G, l, ph * 2 + (item & 1), smem);
            } else if (item < n_gla + n_dif) {
              const int j = item - n_gla;
              int ph, qb;
              if (prm) { ph = xcd * 4 + (3 - j / nqd); qb = j % nqd; }
              else {
                const int half = nqd >> 1, hi = xh_ > 3 - xh_ ? xh_ : 3 - xh_, lo = 3 - hi;
                const int hd = j < half ? hi : lo, jj = j < half ? j : j - half;
                ph = xs_ * 4 + hd; qb = 2 * jj + (hd == xh_ ? 0 : 1);
              }
              diff_item(p, G, l, g * NLAYER + l, ph * nqd + qb, smem);
            } else if (item < n_gla + n_dif + n_att) {
              const int j = item - n_gla - n_dif;
              const int ph = prm ? xcd * 4 + j / nqb : xcd;
              cross_item(p, G, l, ph * nqb + (j % nqb), smem);
            } else if (item < n_gla + n_dif + n_att + n_cmb) {
              const int j = item - n_gla - n_dif - n_att;
              const int tid = otid(), lane = tid & 63, wave = tid >> 6;
#pragma unroll
              for (int i = 0; i < 8; ++i) gla_combine_row(p, l, (long)xcd * 2048 + j * 32 + wave * 8 + i, lane);
            } else {
              prep_tile(p, prep_def_tile(xcd + 8 * (item - n_gla - n_dif - n_att - n_cmb)), smem);
            }
          }
        } else {
          const int n_gla = G.nseq * 8, n_dif = G.nseq * 4 * nqb * 2, n_att = G.nseq * 4 * nqb;
          const int n_prep = (g == 0 && l == 0) ? PREP_DEF : 0;
          const int total = n_gla + n_dif + n_att + n_prep;
          int* ctr = p.counters + 400 + (g * NLAYER + l);
          while (true) {
            if (otid() == 0) s_item = atomicAdd(ctr, 1);
            __syncthreads();
            const int item = s_item;
            __syncthreads();
            if (item >= total) break;
            if (item < n_gla) gla_item(p, G, l, item, smem);
            else if (item < n_gla + n_dif) diff_item(p, G, l, g * NLAYER + l, item - n_gla, smem);
            else if (item < n_gla + n_dif + n_att) cross_item(p, G, l, item - n_gla - n_dif, smem);
            else prep_tile(p, prep_def_tile(item - n_gla - n_dif - n_att), smem);
          }
        }
      }
      xcd_barrier(xb);
      if (!xaware) {
        ROW_IDS
        for (int r = gwave; r < MG; r += nwave) gla_combine_row(p, l, r, lane);
      }
      if (!xaware) xcd_barrier(xb);
      if (xaware) { for (int i = xrank; i < 128; i += xnl) gbr_tile(p, l, (xcd + 8 * (i >> 3)) * 8 + (i & 7), smem); }
      else { for (int t = bid; t < 128 * 8; t += nblk) gbr_tile(p, l, t, smem); }
      const bool team = xaware && xnl == 64;
      if (team) team_barrier(xb); else xcd_barrier(xb);
      {
        const float* xs = l == 0 ? xin : xout;
        if (xaware) { for (int i = xrank; i < 128; i += xnl) gout_tile(p, l, (xcd + 8 * (i >> 3)) * 8 + (i & 7), xs, xout, smem); }
        else { for (int t = bid; t < 128 * 8; t += nblk) gout_tile(p, l, t, xs, xout, smem); }
      }
      const bool teamn = team && l < NLAYER - 1;
      if (teamn) team_barrier(xb); else xcd_barrier(xb);
      ROW_IDS
      if (l < NLAYER - 1) {
        if (teamn) {
          const int wv = xrank * 4 + (tid >> 6);
#pragma unroll 1
          for (int q = 0; q < 8; q += 4) {
            const int i0 = wv + 256 * q;
            const long r0 = (long)(xcd + 8 * (i0 >> 7)) * 128 + (i0 & 127);
            rownorm_bf16_rows4(xout, p.xn, r0, 2 * 8 * 128, lane);
          }
        } else {
          int r = gwave;
          for (; r + 3 * nwave < MG; r += 4 * nwave) rownorm_bf16_rows4(xout, p.xn, r, nwave, lane);
          for (; r < MG; r += nwave) rownorm_bf16_row(xout + (long)r * 1024, p.xn + (long)r * 1024, lane);
        }
      } else {
        for (int r = gwave; r < MG; r += nwave) rownorm_final_row(xout + (long)r * 1024, p.final_g, lane);
        if (g + 1 < NGROUP) {
          const float* xn_in = (g + 1) < 4 ? p.x_prompt + (long)(g + 1) * MG * 1024 : p.x_sample;
          int r = gwave;
          for (; r + 3 * nwave < MG; r += 4 * nwave) rownorm_bf16_rows4(xn_in, p.xn, r, nwave, lane);
          for (; r < MG; r += nwave) rownorm_bf16_row(xn_in + (long)r * 1024, p.xn + (long)r * 1024, lane);
        }
      }
      if (teamn) team_barrier(xb); else xcd_barrier(xb);
    }
  }
}

extern "C" void kernel_launch(void* const* d_in, const int* in_sizes, int n_in, void* d_out, int out_size,
                              void* d_ws, size_t ws_size, hipStream_t stream) {
  static int grid_blocks = 0;
  if (!grid_blocks) {
    int dev = 0, cus = 0, per_cu = 0;
    hipGetDevice(&dev);
    hipDeviceGetAttribute(&cus, hipDeviceAttributeMultiprocessorCount, dev);
    hipFuncSetAttribute((const void*)mega, hipFuncAttributeMaxDynamicSharedMemorySize, SMEM_BYTES);
    hipOccupancyMaxActiveBlocksPerMultiprocessor(&per_cu, mega, 256, SMEM_BYTES);
    if (per_cu > 2) per_cu = 2;
    if (per_cu < 1) per_cu = 1;
    grid_blocks = cus * per_cu;
  }
  Params p{};
  p.x_prompt = (const float*)d_in[0]; p.x_sample = (const float*)d_in[1];
  p.mem_prompt = (const float*)d_in[2]; p.mem_sample = (const float*)d_in[3];
  p.norm_g = (const float*)d_in[4]; p.w_in = (const float*)d_in[5]; p.w2 = (const float*)d_in[6];
  p.b2 = (const float*)d_in[7]; p.gla_norm_g = (const float*)d_in[8]; p.diff_lambda = (const float*)d_in[9];
  p.diff_norm_g = (const float*)d_in[10]; p.mem_norm_g = (const float*)d_in[11]; p.w_mem_kv = (const float*)d_in[12];
  p.w_branch = (const float*)d_in[13]; p.w_out = (const float*)d_in[14]; p.final_g = (const float*)d_in[15];
  p.out = (float*)d_out;
  char* w = (char*)d_ws;
  size_t off = 0;
  auto take = [&](size_t bytes) { char* r = w + off; off += (bytes + 255) & ~(size_t)255; return r; };
  p.Win = (bf16*)take((size_t)NLAYER * NIN * 1024 * 2);
  p.Wkv = (bf16*)take((size_t)NLAYER * 1024 * 1024 * 2);
  p.Wb = (bf16*)take((size_t)NLAYER * 3 * 1024 * 512 * 2);
  p.Wout = (bf16*)take((size_t)NLAYER * 1024 * 1024 * 2);
  p.memn = (bf16*)take((size_t)MEMROWS * 1024 * 2);
  p.kmem = (bf16*)take((size_t)NLAYER * MEMROWS * 512 * 2);
  p.vmemT = (bf16*)take((size_t)NLAYER * MEMROWS * 512 * 2);
  p.xn = (bf16*)take((size_t)MG * 1024 * 2);
  p.proj = (bf16*)take((size_t)MG * NIN * 2);
  p.dvT = (bf16*)take((size_t)MG * 512 * 2);
  p.gvT = (bf16*)take((size_t)MG * 512 * 2);
  p.br = (bf16*)take((size_t)MG * 1536 * 2);
  p.merged = (bf16*)take((size_t)MG * 1024 * 2);
  p.la = (float*)take((size_t)MG * 512 * 4);
  p.glao = (float*)take((size_t)2 * MG * 512 * 4);
  p.park = (float*)take((size_t)grid_blocks * 64 * 256 * 4);
  p.counters = (int*)take(4096);
  p.bar = (unsigned*)take(XCD_BAR_WORDS * 4);
  p.knmax = (int*)take(2048 * 4);
  p.pad_ptr = p.knmax;
  for (int l = 0; l < NLAYER; ++l) p.lam_init[l] = (float)(0.8 - 0.6 * exp(-0.3 * (double)l));
  if (off > ws_size) fprintf(stderr, "workspace too small: need %zu have %zu\n", off, ws_size);
  void* args[] = {&p};
  hipError_t e = hipLaunchCooperativeKernel((void*)mega, dim3(grid_blocks), dim3(256), args, SMEM_BYTES, stream);
  if (e != hipSuccess) fprintf(stderr, "cooperative launch failed: %s (grid %d)\n", hipGetErrorString(e), grid_blocks);
}
```
